# Optimizing an MI355X kernel written in HIP

```python
import math
import jax, jax.numpy as jnp
from jax import lax
import numpy as np

D_MODEL = 1024
BATCH = 8
SEQ = 2048
DEPTH = 1

PLE_DIM = 256
D_FF = 2816
EPS = 1e-6
GLA_HEADS = 4
GLA_DK = 128
GLA_DV = 256
GLA_LOWRANK = 16
GLA_TAU = 16.0
GLA_CHUNK = 64
DSA_HEADS = 8
DSA_LATENT = 128
IDX_HEADS = 8
IDX_DIM = 64
TOPK_MAX = 256
Q_BLOCK = 128
REL_BUCKETS = 32
REL_MAX_DIST = 128

IN_SIZES = (
    GLA_HEADS * GLA_DK,
    GLA_HEADS * GLA_DK,
    GLA_HEADS * GLA_DV,
    GLA_HEADS * GLA_DV,
    GLA_LOWRANK,
    DSA_HEADS * DSA_LATENT,
    DSA_LATENT,
    IDX_HEADS * IDX_DIM,
    IDX_DIM,
    IDX_HEADS,
    2 * D_MODEL,
)
D_IN = sum(IN_SIZES)

kernel_name = "gla_dsa_parallel_hybrid_macaron"


def rms_norm(x, g):
    xf = x.astype(jnp.float32)
    y = xf * lax.rsqrt(jnp.mean(xf * xf, axis=-1, keepdims=True) + EPS)
    return (y * g.astype(jnp.float32)).astype(x.dtype)


def swiglu(x, w_in, w_out):
    gate, up = jnp.split(x @ w_in, 2, axis=-1)
    return (jax.nn.silu(gate) * up) @ w_out


def t5_bucket(dist):
    max_exact = REL_BUCKETS // 2
    d = jnp.maximum(dist, 0)
    ratio = jnp.maximum(d, 1).astype(jnp.float32) / max_exact
    large = max_exact + (jnp.log(ratio) / math.log(REL_MAX_DIST / max_exact)
                         * (REL_BUCKETS - max_exact)).astype(jnp.int32)
    large = jnp.minimum(large, REL_BUCKETS - 1)
    return jnp.where(d < max_exact, d, large)


def gla_chunked(q, k, v, log_a):
    B, H, S, dk = q.shape
    dv = v.shape[-1]
    C = GLA_CHUNK
    N = S // C

    def to_chunks(t):
        return jnp.moveaxis(t.reshape(B, H, N, C, t.shape[-1]), 2, 0)

    causal = jnp.tril(jnp.ones((C, C), dtype=bool))[:, :, None]

    def step(state, inp):
        qi, ki, vi, gi = inp
        b = jnp.cumsum(gi.astype(jnp.float32), axis=2)
        o_inter = jnp.einsum('bhtd,bhde->bhte', qi * jnp.exp(b), state)
        diff = b[:, :, :, None, :] - b[:, :, None, :, :]
        decay = jnp.exp(jnp.where(causal, diff, -jnp.inf))
        scores = jnp.einsum('bhtd,bhsd,bhtsd->bhts', qi, ki, decay)
        o_intra = jnp.einsum('bhts,bhse->bhte', scores, vi)
        b_last = b[:, :, -1:, :]
        k_dec = ki * jnp.exp(b_last - b)
        new_state = (jnp.exp(b_last[:, :, 0, :])[..., None] * state
                     + jnp.einsum('bhsd,bhse->bhde', k_dec, vi))
        return new_state, o_inter + o_intra

    state0 = jnp.zeros((B, H, dk, dv), jnp.float32)
    _, out = lax.scan(step, state0, (to_chunks(q), to_chunks(k), to_chunks(v), to_chunks(log_a)))
    return jnp.moveaxis(out, 0, 2).reshape(B, H, S, dv)


def dsa_attention(q, c_kv, q_idx, k_idx, w_idx, rel_bias):
    B, S, H, dc = q.shape
    top_k = min(TOPK_MAX, S // 4)
    nb = S // Q_BLOCK
    key_pos = jnp.arange(S, dtype=jnp.int32)
    bidx = jnp.arange(B)[:, None, None]

    def blocks(t):
        return jnp.moveaxis(t.reshape(B, nb, Q_BLOCK, *t.shape[2:]), 1, 0)

    def one_block(args):
        blk, qb, qib, wb = args
        q_pos = blk * Q_BLOCK + jnp.arange(Q_BLOCK, dtype=jnp.int32)
        dots = jnp.einsum('bthd,bsd->bths', qib, k_idx).astype(jnp.float32) * (IDX_DIM ** -0.5)
        w = wb.astype(jnp.float32) * (IDX_HEADS ** -0.5)
        score = jnp.einsum('bths,bth->bts', jax.nn.relu(dots), w)
        causal = key_pos[None, :] <= q_pos[:, None]
        score = jnp.where(causal[None], score, -jnp.inf)
        _, sel = lax.top_k(score, top_k)
        valid = sel <= q_pos[None, :, None]
        kv_sel = c_kv[bidx, sel]
        bias = rel_bias[t5_bucket(q_pos[None, :, None] - sel)]
        logits = (jnp.einsum('bthc,btkc->bthk', qb, kv_sel).astype(jnp.float32) * (dc ** -0.5)
                  + jnp.moveaxis(bias, -1, 2).astype(jnp.float32))
        logits = jnp.where(valid[:, :, None, :], logits, -jnp.inf)
        probs = jax.nn.softmax(logits, axis=-1)
        return jnp.einsum('bthk,btkc->bthc', probs.astype(kv_sel.dtype), kv_sel)

    out = lax.map(one_block, (jnp.arange(nb, dtype=jnp.int32), blocks(q), blocks(q_idx), blocks(w_idx)))
    return jnp.moveaxis(out, 0, 1).reshape(B, S, H, dc)


def hybrid_mixer(u, w_in, alpha_w, alpha_b, gla_norm_g, gla_w_out, ckv_g, dsa_w_out, rel_bias, w_out):
    B, S, _ = u.shape
    split_pts = np.cumsum(IN_SIZES)[:-1].tolist()
    (gq, gk, gv, gr, ga, dq, dkv, iq, ik, iw, gates) = jnp.split(u @ w_in, split_pts, axis=-1)

    def heads(t, n):
        return t.reshape(B, S, n, -1).transpose(0, 2, 1, 3)

    log_a = jax.nn.log_sigmoid((ga @ alpha_w + alpha_b).astype(jnp.float32)) / GLA_TAU
    o = gla_chunked(heads(gq, GLA_HEADS) * (GLA_DK ** -0.5), heads(gk, GLA_HEADS),
                    heads(gv, GLA_HEADS), heads(log_a, GLA_HEADS))
    o = rms_norm(o, gla_norm_g.reshape(GLA_HEADS, 1, GLA_DV)).astype(u.dtype)
    o = o.transpose(0, 2, 1, 3).reshape(B, S, GLA_HEADS * GLA_DV) * jax.nn.silu(gr)
    y_gla = o @ gla_w_out

    c_kv = rms_norm(dkv, ckv_g)
    od = dsa_attention(dq.reshape(B, S, DSA_HEADS, DSA_LATENT), c_kv,
                       iq.reshape(B, S, IDX_HEADS, IDX_DIM), ik, iw, rel_bias)
    y_dsa = od.reshape(B, S, DSA_HEADS * DSA_LATENT) @ dsa_w_out

    g_gla, g_dsa = jnp.split(jax.nn.sigmoid(gates), 2, axis=-1)
    return (g_gla * y_gla + g_dsa * y_dsa) @ w_out


def setup_inputs(seed: int = 0) -> dict:
    key = jax.random.key(seed)
    ks = jax.random.split(key, 24)
    L, D, F = DEPTH, D_MODEL, D_FF

    def dense(k, shape, fan_in):
        return jax.random.normal(k, shape, jnp.float32) * (fan_in ** -0.5)

    def gain(k, shape):
        return 1.0 + 0.05 * jax.random.normal(k, shape, jnp.float32)

    return {
        "x": jax.random.normal(ks[0], (BATCH, SEQ, D), jnp.float32),
        "p": jax.random.normal(ks[1], (DEPTH, BATCH, SEQ, PLE_DIM), jnp.float32),
        "ffn1_norm": gain(ks[2], (L, D)),
        "ffn1_w_in": dense(ks[3], (L, D, 2 * F), D),
        "ffn1_w_out": dense(ks[4], (L, F, D), F),
        "mix_norm": gain(ks[5], (L, D)),
        "mix_w_in": dense(ks[6], (L, D, D_IN), D),
        "gla_alpha_w": dense(ks[7], (L, GLA_LOWRANK, GLA_HEADS * GLA_DK), GLA_LOWRANK),
        "gla_alpha_b": 0.1 * jax.random.normal(ks[8], (L, GLA_HEADS * GLA_DK), jnp.float32),
        "gla_out_norm": gain(ks[9], (L, GLA_HEADS * GLA_DV)),
        "gla_w_out": dense(ks[10], (L, GLA_HEADS * GLA_DV, D), GLA_HEADS * GLA_DV),
        "ckv_norm": gain(ks[11], (L, DSA_LATENT)),
        "dsa_w_out": dense(ks[12], (L, DSA_HEADS * DSA_LATENT, D), DSA_HEADS * DSA_LATENT),
        "rel_bias": 0.5 * jax.random.normal(ks[13], (REL_BUCKETS, DSA_HEADS), jnp.float32),
        "mix_w_out": dense(ks[14], (L, D, D), D),
        "ffn2_norm": gain(ks[15], (L, D)),
        "ffn2_w_in": dense(ks[16], (L, D, 2 * F), D),
        "ffn2_w_out": dense(ks[17], (L, F, D), F),
        "ple_norm": gain(ks[18], (L, D)),
        "ple_w_gate": dense(ks[19], (L, D, D), D),
        "ple_w_proj": dense(ks[20], (L, PLE_DIM, D), PLE_DIM),
        "final_norm": gain(ks[21], (D,)),
    }


def reference(x, p, ffn1_norm, ffn1_w_in, ffn1_w_out, mix_norm, mix_w_in, gla_alpha_w, gla_alpha_b,
              gla_out_norm, gla_w_out, ckv_norm, dsa_w_out, rel_bias, mix_w_out, ffn2_norm, ffn2_w_in,
              ffn2_w_out, ple_norm, ple_w_gate, ple_w_proj, final_norm):
    h = x
    for i in range(DEPTH):
        h = h + 0.5 * swiglu(rms_norm(h, ffn1_norm[i]), ffn1_w_in[i], ffn1_w_out[i])
        h = h + hybrid_mixer(rms_norm(h, mix_norm[i]), mix_w_in[i], gla_alpha_w[i], gla_alpha_b[i],
                             gla_out_norm[i], gla_w_out[i], ckv_norm[i], dsa_w_out[i], rel_bias,
                             mix_w_out[i])
        h = h + 0.5 * swiglu(rms_norm(h, ffn2_norm[i]), ffn2_w_in[i], ffn2_w_out[i])
        hn = rms_norm(h, ple_norm[i])
        h = h + jax.nn.sigmoid(hn @ ple_w_gate[i]) * (p[i] @ ple_w_proj[i])
    return rms_norm(h, final_norm)
```

```cpp
#include <hip/hip_runtime.h>
#include <hip/hip_cooperative_groups.h>
#include <cstdio>
#include <cstdint>
namespace cg = cooperative_groups;

#ifndef MK_N_LAUNCHES
#define MK_N_LAUNCHES 1
#endif

#define LAS __attribute__((address_space(3)))
#define GAS __attribute__((address_space(1)))
typedef unsigned short bf16_t;
typedef short bf16x8 __attribute__((ext_vector_type(8)));
typedef float f32x4 __attribute__((ext_vector_type(4)));
typedef float f32x2 __attribute__((ext_vector_type(2)));
typedef unsigned u32x4 __attribute__((ext_vector_type(4)));
typedef unsigned u32x2 __attribute__((ext_vector_type(2)));

constexpr int NB = 8, SEQ = 2048, DM = 1024, MROWS = NB * SEQ;
constexpr int FF = 2816, FF2 = 2 * FF;
constexpr int PLE = 256;
constexpr int NIN = 6912;
constexpr float EPS = 1e-6f;
constexpr int NPHASE = 10;

constexpr size_t MiB = 1u << 20;
constexpr size_t WS_CTL = 0, CTL_BYTES = 65536;
constexpr size_t WS_RSX = 4 * MiB + 512 * 1024;
constexpr size_t WS_RSS1 = 1 * MiB, WS_RSS2 = 2 * MiB, WS_RSS3 = 3 * MiB, WS_RSS4 = 4 * MiB;
constexpr size_t WS_BT3 = 5 * MiB;
constexpr size_t WS_BTA = WS_BT3 + 27 * MiB / 2;
constexpr size_t WS_BTB = WS_BTA + 2 * MiB, WS_BTO = WS_BTB + 2 * MiB;
constexpr size_t WS_WB = WS_BTO + 2 * MiB;
constexpr size_t WS_BT1 = WS_WB, WS_BT2 = WS_WB + 11 * MiB;
constexpr size_t WS_CKV = WS_WB, WS_IK = WS_WB + 4 * MiB, WS_IW = WS_WB + 6 * MiB, WS_GA = WS_WB + 6 * MiB + MiB / 2;
constexpr size_t WS_DECG = WS_WB + 8 * MiB;
constexpr size_t WS_GLAST = WS_WB + 8 * MiB + MiB / 2;
constexpr size_t WS_PB = WS_WB, WS_BTG = WS_WB + 8 * MiB, WS_BTP = WS_WB + 10 * MiB, WS_BT9 = WS_WB + 10 * MiB + MiB / 2;
constexpr size_t WS_HI = 41 * MiB, WS_LO = 73 * MiB;
constexpr size_t WS_BIG = 105 * MiB;
constexpr size_t WS_GQ = WS_BIG, WS_GK = WS_BIG + 16 * MiB, WS_IQ = WS_BIG + 32 * MiB, WS_DQ = WS_BIG + 48 * MiB, WS_GV = WS_BIG + 80 * MiB, WS_GR = WS_BIG + 112 * MiB;
constexpr size_t WS_HID = WS_BIG;
constexpr size_t WS_BT8 = WS_BT3;
constexpr size_t WS_END = WS_BIG + 144 * MiB;
static_assert(WS_BT9 + 11 * MiB / 2 <= WS_HI && WS_GA + MiB <= WS_BT2 && WS_END <= 256 * MiB, "ws map");

constexpr int CW_TMO = 32;
constexpr int CW_GLACNT = 128;
constexpr int CW_GLAST = 8192;
constexpr int CW_QUEUE = 7680;
constexpr int CW_PLEC = 12288;
constexpr int CW_TQ = 48;
constexpr int CW_BAR = 4096;

constexpr int LDS_BYTES = 151552;
constexpr int LDS_EPI = 131072;
constexpr int LDS_MISC = 151552 - 256;

__device__ __forceinline__ unsigned f2bf(float f) { unsigned u = __builtin_bit_cast(unsigned, f); return (u + 0x7fffu + ((u >> 16) & 1u)) >> 16; }
__device__ __forceinline__ float bf2f(unsigned h) { return __builtin_bit_cast(float, h << 16); }
__device__ __forceinline__ unsigned pk2(float lo, float hi) { return f2bf(lo) | (f2bf(hi) << 16); }
__device__ __forceinline__ float bflo(unsigned w) { return __builtin_bit_cast(float, w << 16); }
__device__ __forceinline__ float bfhi(unsigned w) { return __builtin_bit_cast(float, w & 0xffff0000u); }
__device__ __forceinline__ float sigmoidf_(float x) { return __builtin_amdgcn_rcpf(1.0f + __expf(-x)); }
__device__ __forceinline__ float siluf_(float x) { return x * __builtin_amdgcn_rcpf(1.0f + __expf(-x)); }
__device__ __forceinline__ int lane_id() { int l; asm volatile("v_mbcnt_lo_u32_b32 %0, -1, 0\n\tv_mbcnt_hi_u32_b32 %0, -1, %0" : "=v"(l)); return l; }
__device__ __forceinline__ void glds16_asm(const void* gsrc, unsigned lds_dst) { unsigned keep;
    asm volatile("s_mov_b32 %0, m0\n\ts_mov_b32 m0, %2\n\ts_nop 0\n\tglobal_load_lds_dwordx4 %1, off\n\ts_mov_b32 m0, %0" : "=&s"(keep) : "v"(gsrc), "s"(lds_dst) : "memory"); }
__device__ __forceinline__ void glds4_asm(const void* gsrc, unsigned lds_dst) { unsigned keep;
    asm volatile("s_mov_b32 %0, m0\n\ts_mov_b32 m0, %2\n\ts_nop 0\n\tglobal_load_lds_dword %1, off\n\ts_mov_b32 m0, %0" : "=&s"(keep) : "v"(gsrc), "s"(lds_dst) : "memory"); }
#define LDS_ADDR(p) ((unsigned)(size_t)(p))
__device__ __forceinline__ void swap16(float& x, float& y) { asm volatile("s_nop 1\n\tv_permlane16_swap_b32 %0, %1" : "+v"(x), "+v"(y)); }
__device__ __forceinline__ void swap32(float& x, float& y) { asm volatile("s_nop 1\n\tv_permlane32_swap_b32 %0, %1" : "+v"(x), "+v"(y)); }
__device__ __forceinline__ float rows4_sum(float v) { float x = v, y = v; swap16(x, y); v = x + y; x = v; y = v; swap32(x, y); return x + y; }
__device__ __forceinline__ float rows4_max(float v) { float x = v, y = v; swap16(x, y); v = fmaxf(x, y); x = v; y = v; swap32(x, y); return fmaxf(x, y); }
__device__ __forceinline__ float rows4_max_fast(float v) { float x = v, y;
    asm volatile("v_mov_b32 %1, %0\n\ts_nop 1\n\tv_permlane16_swap_b32 %0, %1\n\ts_nop 0\n\tv_max_f32 %0, %0, %1\n\tv_mov_b32 %1, %0\n\ts_nop 1\n\tv_permlane32_swap_b32 %0, %1\n\ts_nop 0\n\tv_max_f32 %0, %0, %1" : "+v"(x), "=&v"(y));
    return x; }
__device__ __forceinline__ void glds16x8_asm(const void* sbase, unsigned o0, unsigned o1, unsigned o2, unsigned o3, unsigned o4, unsigned o5, unsigned o6, unsigned o7,
                                             unsigned l0, unsigned l1, unsigned l2, unsigned l3, unsigned l4, unsigned l5, unsigned l6, unsigned l7) { unsigned keep;
    asm volatile("s_mov_b32 %0, m0\n\t"
                 "s_mov_b32 m0, %10\n\ts_nop 0\n\tglobal_load_lds_dwordx4 %2, %1\n\t"
                 "s_mov_b32 m0, %11\n\ts_nop 0\n\tglobal_load_lds_dwordx4 %3, %1\n\t"
                 "s_mov_b32 m0, %12\n\ts_nop 0\n\tglobal_load_lds_dwordx4 %4, %1\n\t"
                 "s_mov_b32 m0, %13\n\ts_nop 0\n\tglobal_load_lds_dwordx4 %5, %1\n\t"
                 "s_mov_b32 m0, %14\n\ts_nop 0\n\tglobal_load_lds_dwordx4 %6, %1\n\t"
                 "s_mov_b32 m0, %15\n\ts_nop 0\n\tglobal_load_lds_dwordx4 %7, %1\n\t"
                 "s_mov_b32 m0, %16\n\ts_nop 0\n\tglobal_load_lds_dwordx4 %8, %1\n\t"
                 "s_mov_b32 m0, %17\n\ts_nop 0\n\tglobal_load_lds_dwordx4 %9, %1\n\t"
                 "s_mov_b32 m0, %0"
                 : "=&s"(keep) : "s"(sbase), "v"(o0), "v"(o1), "v"(o2), "v"(o3), "v"(o4), "v"(o5), "v"(o6), "v"(o7),
                   "s"(l0), "s"(l1), "s"(l2), "s"(l3), "s"(l4), "s"(l5), "s"(l6), "s"(l7) : "memory"); }
__device__ __forceinline__ int wave_imax(int v) {
    v = max(v, __builtin_amdgcn_update_dpp(0, v, 0xB1, 0xf, 0xf, false)); v = max(v, __builtin_amdgcn_update_dpp(0, v, 0x4E, 0xf, 0xf, false));
    v = max(v, __builtin_amdgcn_update_dpp(0, v, 0x141, 0xf, 0xf, false)); v = max(v, __builtin_amdgcn_update_dpp(0, v, 0x140, 0xf, 0xf, false));
    return max(max(__builtin_amdgcn_readlane(v, 0), __builtin_amdgcn_readlane(v, 16)), max(__builtin_amdgcn_readlane(v, 32), __builtin_amdgcn_readlane(v, 48)));
}
__device__ __forceinline__ unsigned wave_umax(unsigned u) {
    int v = (int)u;
    v = (int)max((unsigned)v, (unsigned)__builtin_amdgcn_update_dpp(0, v, 0xB1, 0xf, 0xf, false)); v = (int)max((unsigned)v, (unsigned)__builtin_amdgcn_update_dpp(0, v, 0x4E, 0xf, 0xf, false));
    v = (int)max((unsigned)v, (unsigned)__builtin_amdgcn_update_dpp(0, v, 0x141, 0xf, 0xf, false)); v = (int)max((unsigned)v, (unsigned)__builtin_amdgcn_update_dpp(0, v, 0x140, 0xf, 0xf, false));
    return max(max((unsigned)__builtin_amdgcn_readlane(v, 0), (unsigned)__builtin_amdgcn_readlane(v, 16)), max((unsigned)__builtin_amdgcn_readlane(v, 32), (unsigned)__builtin_amdgcn_readlane(v, 48)));
}
__device__ __forceinline__ int wave_isum(int v) {
    v += __builtin_amdgcn_update_dpp(0, v, 0xB1, 0xf, 0xf, false);
    v += __builtin_amdgcn_update_dpp(0, v, 0x4E, 0xf, 0xf, false);
    v += __builtin_amdgcn_update_dpp(0, v, 0x141, 0xf, 0xf, false);
    v += __builtin_amdgcn_update_dpp(0, v, 0x140, 0xf, 0xf, false);
    return __builtin_amdgcn_readlane(v, 0) + __builtin_amdgcn_readlane(v, 16) + __builtin_amdgcn_readlane(v, 32) + __builtin_amdgcn_readlane(v, 48);
}
__device__ __forceinline__ float wave_sum(float v) {
#pragma unroll
    for (int o = 1; o < 64; o <<= 1) v += __shfl_xor(v, o);
    return v;
}

namespace pg8 {
constexpr int BM = 256, BK = 64, HALF = 128, HTB = HALF * BK * 2, STAGE_BYTES = 8 * HTB, NXCD = 8, WGM = 4;
__host__ __device__ __forceinline__ int lds_byte(int r, int c) { const int st = (r >> 4) * 2 + (c >> 5), rr = r & 15, cc = c & 31, ob = rr * 64 + cc * 2; return st * 1024 + (ob ^ (((ob >> 9) & 1) << 5)); }
__host__ __device__ __forceinline__ void stage_rc(int b, int& R, int& C) { const int st = b / 1024, sb = b % 1024, swz = sb ^ (((sb >> 9) & 1) << 5); R = (st >> 1) * 16 + swz / 64; C = (st & 1) * 32 + (swz % 64) / 2; }
__host__ __device__ __forceinline__ int perm32(int rho) { const int n = rho >> 4, i = rho & 15; return 8 * (i >> 2) + 4 * n + (i & 3); }

struct Unit { int pm, pn; };
struct Gemm { const bf16_t* A; const bf16_t* Bt; int M, N, K; };

struct StaticOrder {
    int nM, nN, nwg, G, c, wgm;
    __host__ __device__ void init(int M, int N, int G_, int c_, int wgm_ = WGM) { nM = M / BM; nN = N / BM; nwg = nM * nN; G = G_; c = c_; wgm = wgm_; }
    __host__ __device__ bool next(int i, Unit& u) const {
        const long L = (long)i * G + c; if (L >= nwg) return false;
        int wgid = (int)L; { const int q = nwg / NXCD, r = nwg % NXCD, xcd = wgid % NXCD, off = wgid / NXCD; wgid = (xcd < r ? xcd * (q + 1) : r * (q + 1) + (xcd - r) * q) + off; }
        const int nig = wgm * nN, gid = wgid / nig, fm = gid * wgm, gsz = (nM - fm) < wgm ? (nM - fm) : wgm;
        u.pm = fm + ((wgid % nig) % gsz); u.pn = (wgid % nig) / gsz; return true;
    }
    __device__ __forceinline__ void a_ready(const Unit&) const {}
    __device__ __forceinline__ void done(const Unit&) const {}
};

__device__ __forceinline__ unsigned cvt_pk_bf16(float lo, float hi) { unsigned r; asm volatile("v_cvt_pk_bf16_f32 %0, %1, %2" : "=v"(r) : "v"(lo), "v"(hi)); return r; }

template <class T, class = void> struct has_pref { static constexpr bool value = false; };
template <class T> struct has_pref<T, decltype((void)T::PREF)> { static constexpr bool value = true; };
__host__ __device__ constexpr int pref_piece(int k) {
    return ((k >> 1) == 0 ? 4 : (k >> 1) == 1 ? 5 : (k >> 1) == 2 ? 0 : (k >> 1) == 3 ? 1 : (k >> 1) == 4 ? 6 : (k >> 1) == 5 ? 7 : 2) * 16384 + (k & 1) * 8192; }
__host__ __device__ constexpr unsigned pref_tile_off(int k, int LD, int ES) { return (unsigned)((((128 * (k >> 3) + 16 * ((k >> 1) & 3)) * LD) + 128 * (k & 1)) * ES); }
__device__ __forceinline__ unsigned pref_tile_lane(int wr, int wc, int fr, int fq, int LD, int ES) { return (unsigned)((((wr * 64 + fr) * LD) + wc * 32 + 8 * fq) * ES); }
template <int N> __device__ __forceinline__ void wait_vmcnt8_or(int relax) {
    asm volatile("s_cmp_eq_u32 %0, 0\n\ts_cbranch_scc0 1\n\ts_waitcnt vmcnt(8)\n\ts_waitcnt vmcnt(%1)" :: "s"(__builtin_amdgcn_readfirstlane(relax)), "n"(N) : "memory", "scc"); }
template <class Epi, class Sched, bool ALIGN_EPI = true, bool SP2 = true, int NST = 0>
__device__ __forceinline__ void gemm_phase(LAS unsigned char* lds, const Gemm g, const Sched& S, const Epi& E, const int wid) {
    const int lane = lane_id(), tid = wid * 64 + lane, wr = wid >> 2, wc = wid & 3, fr = lane & 15, fq = lane >> 4;
    const int K = g.K, nt = K / BK;
    unsigned voffA[2], voffB[2];
#pragma unroll
    for (int i = 0; i < 2; ++i) { int R, C; stage_rc(tid * 16 + i * 8192, R, C); const int Rb = Epi::PERM ? ((R & ~31) + perm32(R & 31)) : R;
        voffA[i] = (unsigned)(R * K + C) * 2u; voffB[i] = (unsigned)(Rb * K + C) * 2u; }
    const size_t kstep = (size_t)(BK * 2);
    const size_t hstep = (size_t)HALF * K * 2;
    const size_t tstep = 2 * hstep;
    const unsigned ldsw = (unsigned)wid * 1024u;
    const int aoff = lds_byte(wr * 64 + fr, fq * 8), boff = lds_byte(wc * 32 + fr, fq * 8);
#define PG8_SA(b, h) (((b) * 2 + (h)) * HTB)
#define PG8_SB(b, h) ((4 + (b) * 2 + (h)) * HTB)
#define PG8_STAGE(bufoff, gbase, voff) do { _Pragma("unroll") for (int _i = 0; _i < 2; ++_i) \
        __builtin_amdgcn_global_load_lds((const unsigned*)((const char*)(gbase) + (voff)[_i]), (LAS unsigned*)(lds + (bufoff) + ldsw + _i * 8192), 16, 0, 0); } while (0)
#define PG8_LDA(dst, b, h) do { _Pragma("unroll") for (int m = 0; m < 4; ++m) _Pragma("unroll") for (int k = 0; k < 2; ++k) dst[m][k] = *(const LAS bf16x8*)(lds + PG8_SA(b, h) + aoff + m * 2048 + k * 1024); } while (0)
#define PG8_LDB(dst, b, h) do { _Pragma("unroll") for (int n = 0; n < 2; ++n) _Pragma("unroll") for (int k = 0; k < 2; ++k) dst[n][k] = *(const LAS bf16x8*)(lds + PG8_SB(b, h) + boff + n * 2048 + k * 1024); } while (0)
#define PG8_MMA(ai, bj, At, Bt) do { __builtin_amdgcn_s_setprio(1); _Pragma("unroll") for (int m = 0; m < 4; ++m) _Pragma("unroll") for (int n = 0; n < 2; ++n) _Pragma("unroll") for (int k = 0; k < 2; ++k) \
        acc[ai][bj][m][n] = __builtin_amdgcn_mfma_f32_16x16x32_bf16(Bt[n][k], At[m][k], acc[ai][bj][m][n], 0, 0, 0); __builtin_amdgcn_s_setprio(0); } while (0)
#define PG8_WAIT_V(n) asm volatile("s_waitcnt vmcnt(" #n ")" ::: "memory")
#define PG8_WAIT_L(n) asm volatile("s_waitcnt lgkmcnt(" #n ")" ::: "memory")
#define PG8_BAR __builtin_amdgcn_s_barrier()
#define PG8_SCHED __builtin_amdgcn_sched_barrier(0)
    Unit cur, nxt; int ui = 0;
    if (!S.next(0, cur)) return;
    f32x4 acc[2][2][4][2];
#pragma unroll
    for (int a = 0; a < 2; ++a)
#pragma unroll
        for (int b = 0; b < 2; ++b)
#pragma unroll
            for (int m = 0; m < 4; ++m)
#pragma unroll
                for (int n = 0; n < 2; ++n) acc[a][b][m][n] = (f32x4){0.f, 0.f, 0.f, 0.f};
    bf16x8 At[4][2], B0[2][2], B1[2][2];
    const char* cA = (const char*)g.A + (size_t)cur.pm * tstep; const char* cB = (const char*)g.Bt + (size_t)cur.pn * tstep;
    S.a_ready(cur);
    if constexpr (SP2) {
        PG8_STAGE(PG8_SB(0, 0), cB, voffB); PG8_STAGE(PG8_SB(0, 1), cB + hstep, voffB); PG8_STAGE(PG8_SA(0, 0), cA, voffA); PG8_STAGE(PG8_SA(0, 1), cA + hstep, voffA);
        if (wr == 1) PG8_BAR;
        PG8_WAIT_V(2); PG8_BAR;
        PG8_STAGE(PG8_SB(1, 0), cB + kstep, voffB); PG8_STAGE(PG8_SA(1, 0), cA + kstep, voffA); PG8_STAGE(PG8_SB(1, 1), cB + hstep + kstep, voffB);
        PG8_WAIT_V(6); PG8_BAR;
    } else {
        PG8_STAGE(PG8_SB(0, 0), cB, voffB); PG8_STAGE(PG8_SA(0, 0), cA, voffA); PG8_STAGE(PG8_SB(0, 1), cB + hstep, voffB); PG8_STAGE(PG8_SA(0, 1), cA + hstep, voffA);
        if (wr == 1) PG8_BAR;
        PG8_WAIT_V(4); PG8_BAR;
        PG8_STAGE(PG8_SB(1, 0), cB + kstep, voffB); PG8_STAGE(PG8_SA(1, 0), cA + kstep, voffA); PG8_STAGE(PG8_SB(1, 1), cB + hstep + kstep, voffB);
        PG8_WAIT_V(6); PG8_BAR;
    }
    for (;;) {
        const bool has_next = S.next(ui + 1, nxt);
        const char* nA = has_next ? (const char*)g.A + (size_t)nxt.pm * tstep : cA; const char* nB = has_next ? (const char*)g.Bt + (size_t)nxt.pn * tstep : cB;
        const char* pbase = nullptr;
        if constexpr (has_pref<Epi>::value) { if (!has_next) pbase = E.pref_base(cur); }
        for (int t = 0; t < nt; t += 2) {
            const bool last = (t == nt - 2);
            const char* a1 = cA + (size_t)(t + 1) * kstep;
            const char* a2 = last ? nA : cA + (size_t)(t + 2) * kstep; const char* b2 = last ? nB : cB + (size_t)(t + 2) * kstep;
            const char* a3 = a2 + kstep; const char* b3 = b2 + kstep;
            if (last && has_next) S.a_ready(nxt);
            const bool pref = has_pref<Epi>::value && last && (pbase != nullptr);
            unsigned plo = 0u;
            if constexpr (has_pref<Epi>::value) { const int l_ = lane_id(); plo = Epi::pref_lane(wr, wc, l_ & 15, l_ >> 4); }
#define PG8_STAGE_P(bufoff, gbase, voff, j0) do { if constexpr (has_pref<Epi>::value) { const char* gb_ = pref ? pbase : (const char*)(gbase); \
                _Pragma("unroll") for (int _i = 0; _i < 2; ++_i) { const unsigned vo_ = pref ? plo + Epi::pref_off((j0) + _i) : (voff)[_i]; \
                    __builtin_amdgcn_global_load_lds((const unsigned*)(gb_ + vo_), (LAS unsigned*)(lds + (bufoff) + ldsw + _i * 8192), 16, 0, 0); } } \
            else PG8_STAGE(bufoff, gbase, voff); } while (0)
            if constexpr (SP2) {
            const int relax = ((NST > 0) && (t == 0) && (ui > 0)) ? 1 : 0;
            PG8_LDB(B0, 0, 0); PG8_LDB(B1, 0, 1); PG8_SCHED; PG8_LDA(At, 0, 0); PG8_STAGE(PG8_SA(1, 1), a1 + hstep, voffA);
            if constexpr (NST > 0) wait_vmcnt8_or<8 + NST>(relax); else PG8_WAIT_V(8);
            PG8_WAIT_L(0); PG8_BAR; PG8_MMA(0, 0, At, B0); PG8_MMA(0, 1, At, B1); PG8_BAR; PG8_SCHED;
            PG8_LDA(At, 0, 1); PG8_STAGE_P(PG8_SB(0, 0), b2, voffB, 0); PG8_STAGE_P(PG8_SB(0, 1), b2 + hstep, voffB, 2); PG8_STAGE_P(PG8_SA(0, 0), a2, voffA, 4);
            if constexpr (NST > 0) wait_vmcnt8_or<8 + NST>(relax); else PG8_WAIT_V(8);
            PG8_WAIT_L(0); PG8_BAR; PG8_MMA(1, 0, At, B0); PG8_MMA(1, 1, At, B1); PG8_BAR; PG8_SCHED;
            PG8_LDB(B0, 1, 0); PG8_LDB(B1, 1, 1); PG8_SCHED; PG8_LDA(At, 1, 0); PG8_STAGE_P(PG8_SA(0, 1), a2 + hstep, voffA, 6);
            PG8_WAIT_V(8); PG8_WAIT_L(0); PG8_BAR; PG8_MMA(0, 0, At, B0); PG8_MMA(0, 1, At, B1); PG8_BAR; PG8_SCHED;
            PG8_LDA(At, 1, 1); PG8_STAGE_P(PG8_SB(1, 0), b3, voffB, 8); PG8_STAGE_P(PG8_SB(1, 1), b3 + hstep, voffB, 10); PG8_STAGE_P(PG8_SA(1, 0), a3, voffA, 12);
            PG8_WAIT_V(8); PG8_WAIT_L(0); PG8_BAR; PG8_MMA(1, 0, At, B0); PG8_MMA(1, 1, At, B1); PG8_BAR; PG8_SCHED;
            } else {
            PG8_LDB(B0, 0, 0); PG8_SCHED; PG8_LDA(At, 0, 0); PG8_STAGE(PG8_SA(1, 1), a1 + hstep, voffA);
            PG8_WAIT_L(8); PG8_BAR; PG8_WAIT_L(0); PG8_MMA(0, 0, At, B0); PG8_BAR; PG8_SCHED;
            PG8_LDB(B1, 0, 1); PG8_STAGE(PG8_SB(0, 0), b2, voffB);
            PG8_BAR; PG8_WAIT_L(0); PG8_MMA(0, 1, At, B1); PG8_BAR;
            PG8_LDA(At, 0, 1); PG8_STAGE(PG8_SA(0, 0), a2, voffA);
            PG8_BAR; PG8_WAIT_L(0); PG8_MMA(1, 0, At, B0); PG8_BAR; PG8_SCHED;
            PG8_STAGE(PG8_SB(0, 1), b2 + hstep, voffB);
            PG8_WAIT_V(6); PG8_BAR; PG8_MMA(1, 1, At, B1); PG8_BAR;
            PG8_LDB(B0, 1, 0); PG8_SCHED; PG8_LDA(At, 1, 0); PG8_STAGE(PG8_SA(0, 1), a2 + hstep, voffA);
            PG8_WAIT_L(8); PG8_BAR; PG8_WAIT_L(0); PG8_MMA(0, 0, At, B0); PG8_BAR; PG8_SCHED;
            PG8_LDB(B1, 1, 1); PG8_STAGE(PG8_SB(1, 0), b3, voffB);
            PG8_BAR; PG8_WAIT_L(0); PG8_MMA(0, 1, At, B1); PG8_BAR;
            PG8_LDA(At, 1, 1); PG8_STAGE(PG8_SA(1, 0), a3, voffA);
            PG8_BAR; PG8_WAIT_L(0); PG8_MMA(1, 0, At, B0); PG8_BAR; PG8_SCHED;
            PG8_STAGE(PG8_SB(1, 1), b3 + hstep, voffB);
            PG8_WAIT_V(6); PG8_BAR; PG8_MMA(1, 1, At, B1); PG8_BAR;
            }
        }
        if constexpr (ALIGN_EPI) { if (wr == 0) PG8_BAR; }
        E(acc, cur, wr, wc, fr, fq); S.done(cur);
        if (!has_next) break;
#pragma unroll
        for (int a = 0; a < 2; ++a)
#pragma unroll
            for (int b = 0; b < 2; ++b)
#pragma unroll
                for (int m = 0; m < 4; ++m)
#pragma unroll
                    for (int n = 0; n < 2; ++n) acc[a][b][m][n] = (f32x4){0.f, 0.f, 0.f, 0.f};
        cur = nxt; cA = nA; cB = nB; ++ui;
        if constexpr (ALIGN_EPI) { if (wr == 1) PG8_BAR; }
    }
    PG8_WAIT_V(0);
    if constexpr (!ALIGN_EPI) { if (wr == 0) PG8_BAR; }
    PG8_BAR;
#undef PG8_SA
#undef PG8_SB
#undef PG8_STAGE
#undef PG8_STAGE_P
#undef PG8_LDA
#undef PG8_LDB
#undef PG8_MMA
#undef PG8_WAIT_V
#undef PG8_WAIT_L
#undef PG8_BAR
#undef PG8_SCHED
}

__device__ __forceinline__ float row_rs(const float* rss, int row, int fq) {
    const f32x4 p = *(const f32x4*)(rss + (size_t)row * 16 + 4 * fq);
    float s = (p[0] + p[1]) + (p[2] + p[3]);
    s = rows4_sum(s);
    return __builtin_amdgcn_rsqf(s * (1.0f / DM) + EPS);
}

struct EpiSwiglu {
    static constexpr bool PERM = true;
    bf16_t* H; const float* rss;
    __device__ __forceinline__ void operator()(const f32x4 (&acc)[2][2][4][2], const Unit& u, int wr, int wc, int fr, int fq) const {
        const int row0 = u.pm * BM + wr * 64 + fr, col0 = u.pn * HALF + wc * 32 + 8 * fq;
#pragma unroll
        for (int ai = 0; ai < 2; ++ai)
#pragma unroll
            for (int m = 0; m < 4; ++m) {
                const int row = row0 + ai * HALF + m * 16;
                const float rs = rss ? row_rs(rss, row, fq) : 1.0f;
                const f32x4 g0 = acc[ai][0][m][0] * rs, g1 = acc[ai][0][m][1] * rs, u0 = acc[ai][1][m][0] * rs, u1 = acc[ai][1][m][1] * rs;
                float h[8];
#pragma unroll
                for (int j = 0; j < 4; ++j) { h[j] = siluf_(g0[j]) * u0[j]; h[4 + j] = siluf_(g1[j]) * u1[j]; }
                u32x4 w; w.x = cvt_pk_bf16(h[0], h[1]); w.y = cvt_pk_bf16(h[2], h[3]); w.z = cvt_pk_bf16(h[4], h[5]); w.w = cvt_pk_bf16(h[6], h[7]);
                *(u32x4*)(H + (size_t)row * FF + col0) = w;
            }
    }
};

struct EpiResid {
    static constexpr bool PERM = true, PREF = true;
    const float* X; bf16_t* HI; float* rss; float alpha; LAS unsigned char* plds;
    __device__ __forceinline__ const char* pref_base(const Unit& u) const { return (const char*)(X + ((size_t)u.pm * BM * DM + (size_t)u.pn * BM)); }
    static __device__ __forceinline__ unsigned pref_lane(int wr, int wc, int fr, int fq) { return pref_tile_lane(wr, wc, fr, fq, 1024, 4); }
    static constexpr unsigned pref_off(int j) { return pref_tile_off(j >> 1, 1024, 4) + 16u * (unsigned)(j & 1); }
    __device__ __forceinline__ void operator()(const f32x4 (&acc)[2][2][4][2], const Unit& u, int wr, int wc, int, int) const {
        const int lane_ = lane_id(), fr = lane_ & 15, fq = lane_ >> 4;
        const int row0 = u.pm * BM + wr * 64 + fr, col0 = u.pn * BM + wc * 32 + 8 * fq;
        const LAS unsigned char* mine = plds + (wr * 4 + wc) * 1024 + lane_ * 16;
        asm volatile("s_waitcnt vmcnt(0)" ::: "memory");
#pragma unroll
        for (int ai = 0; ai < 2; ++ai)
#pragma unroll
            for (int m = 0; m < 4; ++m) {
                const int row = row0 + ai * HALF + m * 16; float ss = 0.f;
#pragma unroll
                for (int bj = 0; bj < 2; ++bj) {
                    const size_t off = (size_t)row * DM + col0 + bj * HALF;
                    const int k = ai * 8 + m * 2 + bj;
                    f32x4 x0, x1;
                    if (2 * k < 14) x0 = *(const LAS f32x4*)(mine + pref_piece(2 * k)); else x0 = *(const f32x4*)(X + off);
                    if (2 * k + 1 < 14) x1 = *(const LAS f32x4*)(mine + pref_piece(2 * k + 1)); else x1 = *(const f32x4*)(X + off + 4);
                    float v[8];
#pragma unroll
                    for (int j = 0; j < 4; ++j) { v[j] = x0[j] + alpha * acc[ai][bj][m][0][j]; v[4 + j] = x1[j] + alpha * acc[ai][bj][m][1][j]; }
                    u32x4 hw;
#pragma unroll
                    for (int j = 0; j < 4; ++j) {
                        hw[j] = cvt_pk_bf16(v[2 * j], v[2 * j + 1]);
                        ss += v[2 * j] * v[2 * j] + v[2 * j + 1] * v[2 * j + 1];
                    }
                    *(u32x4*)(HI + off) = hw;
                }
                ss = rows4_sum(ss);
                if (fq == 0) rss[(size_t)row * 16 + 4 * u.pn + wc] = ss;
            }
    }
};

struct EpiResidH {
    static constexpr bool PERM = true, PREF = true;
    bf16_t* HI; float* rss; float alpha; LAS unsigned char* plds; const float* bscale;
    __device__ __forceinline__ const char* pref_base(const Unit& u) const { return (const char*)(HI + ((size_t)u.pm * BM * DM + (size_t)u.pn * BM)); }
    static __device__ __forceinline__ unsigned pref_lane(int wr, int wc, int fr, int fq) { return pref_tile_lane(wr, wc, fr, fq, 1024, 2); }
    static constexpr unsigned pref_off(int j) { return pref_tile_off(j, 1024, 2); }
    __device__ __forceinline__ void operator()(const f32x4 (&acc)[2][2][4][2], const Unit& u, int wr, int wc, int, int) const {
        const int lane_ = lane_id(), fr = lane_ & 15, fq = lane_ >> 4;
        const int row0 = u.pm * BM + wr * 64 + fr, col0 = u.pn * BM + wc * 32 + 8 * fq;
        const LAS unsigned char* mine = plds + (wr * 4 + wc) * 1024 + lane_ * 16;
        asm volatile("s_waitcnt vmcnt(0)" ::: "memory");
#pragma unroll
        for (int ai = 0; ai < 2; ++ai)
#pragma unroll
            for (int m = 0; m < 4; ++m) {
                const int row = row0 + ai * HALF + m * 16; float ss = 0.f;
                const float bs = bscale ? bscale[row] : 1.0f;
#pragma unroll
                for (int bj = 0; bj < 2; ++bj) {
                    const size_t off = (size_t)row * DM + col0 + bj * HALF;
                    const int k = ai * 8 + m * 2 + bj;
                    u32x4 bw;
                    if (k < 14) bw = *(const LAS u32x4*)(mine + pref_piece(k)); else bw = *(const u32x4*)(HI + off);
                    float v[8];
#pragma unroll
                    for (int j = 0; j < 2; ++j) {
                        v[2 * j]     = bflo(bw[j]) * bs     + alpha * acc[ai][bj][m][0][2 * j];     v[2 * j + 1]     = bfhi(bw[j]) * bs     + alpha * acc[ai][bj][m][0][2 * j + 1];
                        v[4 + 2 * j] = bflo(bw[2 + j]) * bs + alpha * acc[ai][bj][m][1][2 * j];     v[4 + 2 * j + 1] = bfhi(bw[2 + j]) * bs + alpha * acc[ai][bj][m][1][2 * j + 1]; }
                    u32x4 hw;
#pragma unroll
                    for (int j = 0; j < 4; ++j) { hw[j] = cvt_pk_bf16(v[2 * j], v[2 * j + 1]); ss += v[2 * j] * v[2 * j] + v[2 * j + 1] * v[2 * j + 1]; }
                    *(u32x4*)(HI + off) = hw;
                }
                ss = rows4_sum(ss);
                if (fq == 0) rss[(size_t)row * 16 + 4 * u.pn + wc] = ss;
            }
    }
};

struct EpiInproj {
    static constexpr bool PERM = true;
    unsigned char* ws; bf16_t* gates; const float* rss; const float* ckv_g; LAS unsigned char* lds;
    __device__ __forceinline__ void operator()(const f32x4 (&acc)[2][2][4][2], const Unit& u, int wr, int wc, int fr, int fq) const {
        const int row0 = u.pm * BM + wr * 64 + fr;
        const int pn = u.pn;
        if (pn < 26) {
            bf16_t* dst; int ld, ct; float sc = 1.0f;
            if (pn < 2)       { dst = (bf16_t*)(ws + WS_GQ); ld = 512;  ct = pn;      sc = 0.08838834764831845f; }
            else if (pn < 4)  { dst = (bf16_t*)(ws + WS_GK); ld = 512;  ct = pn - 2; }
            else if (pn < 8)  { dst = (bf16_t*)(ws + WS_GV); ld = 1024; ct = pn - 4; }
            else if (pn < 12) { dst = (bf16_t*)(ws + WS_GR); ld = 1024; ct = pn - 8; }
            else if (pn < 16) { dst = (bf16_t*)(ws + WS_DQ); ld = 1024; ct = pn - 12; }
            else if (pn < 18) { dst = (bf16_t*)(ws + WS_IQ); ld = 512;  ct = pn - 16; }
            else              { dst = gates;                 ld = 2048; ct = pn - 18; }
            const int col0 = ct * BM + wc * 32 + 8 * fq;
#pragma unroll
            for (int ai = 0; ai < 2; ++ai)
#pragma unroll
                for (int m = 0; m < 4; ++m) {
                    const int row = row0 + ai * HALF + m * 16;
                    const float rs = row_rs(rss, row, fq) * sc;
#pragma unroll
                    for (int bj = 0; bj < 2; ++bj) {
                        const f32x4 v0 = acc[ai][bj][m][0] * rs, v1 = acc[ai][bj][m][1] * rs;
                        u32x4 w; w.x = cvt_pk_bf16(v0[0], v0[1]); w.y = cvt_pk_bf16(v0[2], v0[3]); w.z = cvt_pk_bf16(v1[0], v1[1]); w.w = cvt_pk_bf16(v1[2], v1[3]);
                        *(u32x4*)(dst + (size_t)row * ld + col0 + bj * HALF) = w;
                    }
                }
        } else {
            LAS float* red = (LAS float*)(lds + LDS_EPI);
            float rsv[2][4];
#pragma unroll
            for (int ai = 0; ai < 2; ++ai)
#pragma unroll
                for (int m = 0; m < 4; ++m) {
                    const int row = row0 + ai * HALF + m * 16;
                    const float rs = row_rs(rss, row, fq); rsv[ai][m] = rs;
                    const f32x4 v0 = acc[ai][0][m][0] * rs, v1 = acc[ai][0][m][1] * rs;
                    float ss = (v0[0] * v0[0] + v0[1] * v0[1]) + (v0[2] * v0[2] + v0[3] * v0[3]) + (v1[0] * v1[0] + v1[1] * v1[1]) + (v1[2] * v1[2] + v1[3] * v1[3]);
                    ss = rows4_sum(ss);
                    if (fq == 0) red[(wr * 64 + fr + ai * HALF + m * 16) * 4 + wc] = ss;
                }
            asm volatile("s_waitcnt lgkmcnt(0)" ::: "memory"); __builtin_amdgcn_s_barrier(); asm volatile("" ::: "memory");
            bf16_t* CKV = (bf16_t*)(ws + WS_CKV); bf16_t* IK = (bf16_t*)(ws + WS_IK); float* IW = (float*)(ws + WS_IW); float* GA = (float*)(ws + WS_GA);
            const int c0 = wc * 32 + 8 * fq;
            const f32x4 g0 = *(const f32x4*)(ckv_g + c0), g1 = *(const f32x4*)(ckv_g + c0 + 4);
#pragma unroll
            for (int ai = 0; ai < 2; ++ai)
#pragma unroll
                for (int m = 0; m < 4; ++m) {
                    const int rl = wr * 64 + fr + ai * HALF + m * 16; const int row = u.pm * BM + rl; const float rs = rsv[ai][m];
                    const f32x4 t4 = *(const LAS f32x4*)(red + rl * 4);
                    const float rstd = __builtin_amdgcn_rsqf(((t4[0] + t4[1]) + (t4[2] + t4[3])) * (1.0f / 128.0f) + EPS);
                    { const f32x4 v0 = acc[ai][0][m][0] * (rs * rstd) * g0, v1 = acc[ai][0][m][1] * (rs * rstd) * g1;
                      u32x4 w; w.x = cvt_pk_bf16(v0[0], v0[1]); w.y = cvt_pk_bf16(v0[2], v0[3]); w.z = cvt_pk_bf16(v1[0], v1[1]); w.w = cvt_pk_bf16(v1[2], v1[3]);
                      *(u32x4*)(CKV + (size_t)row * 128 + c0) = w; }
                    const f32x4 v0 = acc[ai][1][m][0] * rs, v1 = acc[ai][1][m][1] * rs;
                    if (wc < 2) { u32x4 w; w.x = cvt_pk_bf16(v0[0], v0[1]); w.y = cvt_pk_bf16(v0[2], v0[3]); w.z = cvt_pk_bf16(v1[0], v1[1]); w.w = cvt_pk_bf16(v1[2], v1[3]);
                        *(u32x4*)(IK + (size_t)row * 64 + c0) = w; }
                    else if (wc == 2 && fq < 2) { *(f32x4*)(GA + (size_t)row * 16 + 8 * fq) = v0; *(f32x4*)(GA + (size_t)row * 16 + 8 * fq + 4) = v1; }
                    else if (wc == 2 && fq == 2) { *(f32x4*)(IW + (size_t)row * 8) = v0; *(f32x4*)(IW + (size_t)row * 8 + 4) = v1; }
                }
            asm volatile("s_waitcnt lgkmcnt(0)" ::: "memory"); __builtin_amdgcn_s_barrier(); asm volatile("" ::: "memory");
        }
    }
};

struct EpiMerge {
    static constexpr bool PERM = true, PREF = true;
    bf16_t* MG; const bf16_t* gates; int pass; LAS unsigned char* plds;
    __device__ __forceinline__ const char* pref_base(const Unit& u) const { return (const char*)(gates + ((size_t)u.pm * BM * 2048 + (size_t)pass * 1024 + (size_t)u.pn * BM)); }
    static __device__ __forceinline__ unsigned pref_lane(int wr, int wc, int fr, int fq) { return pref_tile_lane(wr, wc, fr, fq, 2048, 2); }
    static constexpr unsigned pref_off(int j) { return pref_tile_off(j, 2048, 2); }
    __device__ __forceinline__ void operator()(const f32x4 (&acc)[2][2][4][2], const Unit& u, int wr, int wc, int, int) const {
        const int lane_ = lane_id(), fr = lane_ & 15, fq = lane_ >> 4;
        const int row0 = u.pm * BM + wr * 64 + fr, col0 = u.pn * BM + wc * 32 + 8 * fq;
        const LAS unsigned char* mine = plds + (wr * 4 + wc) * 1024 + lane_ * 16;
        asm volatile("s_waitcnt vmcnt(0)" ::: "memory");
#pragma unroll
        for (int ai = 0; ai < 2; ++ai)
#pragma unroll
            for (int m = 0; m < 4; ++m) {
                const int row = row0 + ai * HALF + m * 16;
#pragma unroll
                for (int bj = 0; bj < 2; ++bj) {
                    const int col = col0 + bj * HALF;
                    const int k = ai * 8 + m * 2 + bj;
                    u32x4 gw;
                    if (k < 14) gw = *(const LAS u32x4*)(mine + pref_piece(k)); else gw = *(const u32x4*)(gates + (size_t)row * 2048 + pass * 1024 + col);
                    float v[8];
#pragma unroll
                    for (int j = 0; j < 4; ++j) { v[j] = acc[ai][bj][m][0][j]; v[4 + j] = acc[ai][bj][m][1][j]; }
#pragma unroll
                    for (int j = 0; j < 4; ++j) { v[2 * j] *= sigmoidf_(bflo(gw[j])); v[2 * j + 1] *= sigmoidf_(bfhi(gw[j])); }
                    if (pass) { const u32x4 pw = *(const u32x4*)(MG + (size_t)row * DM + col);
#pragma unroll
                        for (int j = 0; j < 4; ++j) { v[2 * j] += bflo(pw[j]); v[2 * j + 1] += bfhi(pw[j]); } }
                    u32x4 w; w.x = cvt_pk_bf16(v[0], v[1]); w.y = cvt_pk_bf16(v[2], v[3]); w.z = cvt_pk_bf16(v[4], v[5]); w.w = cvt_pk_bf16(v[6], v[7]);
                    *(u32x4*)(MG + (size_t)row * DM + col) = w;
                }
            }
    }
};

__device__ __forceinline__ unsigned cvt_pk_bf16_nv(float lo, float hi) { unsigned r; asm("v_cvt_pk_bf16_f32 %0, %1, %2" : "=v"(r) : "v"(lo), "v"(hi)); return r; }
struct EpiPle {
    static constexpr bool PERM = true;
    bf16_t* PROJ;
    __device__ __forceinline__ void operator()(const f32x4 (&acc)[2][2][4][2], const Unit& u, int wr, int wc, int, int) const {
        const int lane_ = lane_id(), fr = lane_ & 15, fq = lane_ >> 4;
        const int row0 = u.pm * BM + wr * 64 + fr, col0 = u.pn * BM + wc * 32 + 8 * fq;
#pragma unroll
        for (int ai = 0; ai < 2; ++ai)
#pragma unroll
            for (int m = 0; m < 4; ++m) {
                const int row = row0 + ai * HALF + m * 16;
#pragma unroll
                for (int bj = 0; bj < 2; ++bj) { const size_t off = (size_t)row * DM + col0 + bj * HALF;
                    const f32x4 c0 = acc[ai][bj][m][0], c1 = acc[ai][bj][m][1];
                    u32x4 w; w.x = cvt_pk_bf16_nv(c0[0], c0[1]); w.y = cvt_pk_bf16_nv(c0[2], c0[3]); w.z = cvt_pk_bf16_nv(c1[0], c1[1]); w.w = cvt_pk_bf16_nv(c1[2], c1[3]);
                    *(u32x4*)(PROJ + off) = w; }
            }
    }
};

struct EpiPleFinal {
    static constexpr bool PERM = true, PREF = true;
    float* OUT; const bf16_t* HI; const bf16_t* PROJ; const float* rss_in; const float* gfin; unsigned* xbuf; unsigned* cnt; unsigned* tmo; LAS unsigned char* lds;
    __device__ __forceinline__ const char* pref_base(const Unit& u) const { return (const char*)(HI + ((size_t)u.pm * BM * DM + (size_t)u.pn * BM)); }
    static __device__ __forceinline__ unsigned pref_lane(int wr, int wc, int fr, int fq) { return pref_tile_lane(wr, wc, fr, fq, 1024, 2); }
    static constexpr unsigned pref_off(int j) { return pref_tile_off(j, 1024, 2); }
    __device__ __forceinline__ void operator()(f32x4 (&acc)[2][2][4][2], const Unit& u, int wr, int wc, int fr, int fq) const {
        const int row0 = u.pm * BM + wr * 64 + fr, col0 = u.pn * BM + wc * 32 + 8 * fq;
        LAS float* P = (LAS float*)(lds + LDS_EPI); LAS float* S = P + 1024; LAS unsigned* flag = (LAS unsigned*)(S + 256);
        const LAS unsigned char* mine = lds + (wr * 4 + wc) * 1024 + (fr + 16 * fq) * 16;
        asm volatile("s_waitcnt vmcnt(0)" ::: "memory");
#pragma unroll
        for (int ai = 0; ai < 2; ++ai)
#pragma unroll
            for (int m = 0; m < 4; ++m) {
                const int row = row0 + ai * HALF + m * 16;
                const float rs = row_rs(rss_in, row, fq); float ss = 0.f;
#pragma unroll
                for (int bj = 0; bj < 2; ++bj) { const size_t off = (size_t)row * DM + col0 + bj * HALF;
                    const u32x4 pw = *(const u32x4*)(PROJ + off);
                    const int k = ai * 8 + m * 2 + bj;
                    u32x4 hw;
                    if (k < 14) hw = *(const LAS u32x4*)(mine + pref_piece(k)); else hw = *(const u32x4*)(HI + off);
                    f32x4 o0, o1;
#pragma unroll
                    for (int j = 0; j < 2; ++j) {
                        o0[2 * j]     = bflo(hw[j])     + sigmoidf_(rs * acc[ai][bj][m][0][2 * j])     * bflo(pw[j]);
                        o0[2 * j + 1] = bfhi(hw[j])     + sigmoidf_(rs * acc[ai][bj][m][0][2 * j + 1]) * bfhi(pw[j]);
                        o1[2 * j]     = bflo(hw[2 + j]) + sigmoidf_(rs * acc[ai][bj][m][1][2 * j])     * bflo(pw[2 + j]);
                        o1[2 * j + 1] = bfhi(hw[2 + j]) + sigmoidf_(rs * acc[ai][bj][m][1][2 * j + 1]) * bfhi(pw[2 + j]); }
#pragma unroll
                    for (int j = 0; j < 4; ++j) ss += o0[j] * o0[j] + o1[j] * o1[j];
                    acc[ai][bj][m][0] = o0; acc[ai][bj][m][1] = o1; }
                ss = rows4_sum(ss);
                if (fq == 0) P[(wr * 64 + fr + ai * HALF + m * 16) * 4 + wc] = ss;
            }
        asm volatile("s_waitcnt lgkmcnt(0)" ::: "memory"); __builtin_amdgcn_s_barrier(); asm volatile("" ::: "memory");
        const int wid = wr * 4 + wc, lane = fr + 16 * fq, rowl = wid * 32 + (lane & 31);
        if (lane < 32) { const f32x4 t4 = *(const LAS f32x4*)(P + rowl * 4);
            __hip_atomic_store(xbuf + ((size_t)(u.pm * BM + rowl) * 4 + u.pn), __builtin_bit_cast(unsigned, (t4[0] + t4[1]) + (t4[2] + t4[3])), __ATOMIC_RELAXED, __HIP_MEMORY_SCOPE_AGENT); }
        asm volatile("s_waitcnt vmcnt(0)" ::: "memory");
        if (lane == 0) __hip_atomic_fetch_add(cnt + 64 * u.pm, 1u, __ATOMIC_RELAXED, __HIP_MEMORY_SCOPE_AGENT);
        if (wid == 0) { unsigned sp = 0; bool dead = false;
            while ((unsigned)__builtin_amdgcn_readfirstlane(__hip_atomic_load(cnt + 64 * u.pm, __ATOMIC_RELAXED, __HIP_MEMORY_SCOPE_AGENT)) < 32u) {
                __builtin_amdgcn_s_sleep(2); if (++sp > (1u << 22)) { dead = true; break; } }
            __builtin_amdgcn_fence(__ATOMIC_ACQUIRE, "agent");
            if (lane == 0) { flag[0] = dead ? 1u : 0u; if (dead) atomicAdd(tmo, 1u); } }
        asm volatile("s_waitcnt vmcnt(0) lgkmcnt(0)" ::: "memory"); __builtin_amdgcn_s_barrier(); asm volatile("" ::: "memory");
        if (lane < 32) { float tot = 0.f;
#pragma unroll
            for (int t = 0; t < 4; ++t) tot += __builtin_bit_cast(float, __hip_atomic_load(xbuf + ((size_t)(u.pm * BM + rowl) * 4 + t), __ATOMIC_RELAXED, __HIP_MEMORY_SCOPE_AGENT));
            S[rowl] = __builtin_amdgcn_rsqf(tot * (1.0f / DM) + EPS); }
        asm volatile("s_waitcnt lgkmcnt(0)" ::: "memory"); __builtin_amdgcn_s_barrier(); asm volatile("" ::: "memory");
        f32x4 gv[2][2];
#pragma unroll
        for (int bj = 0; bj < 2; ++bj) { gv[bj][0] = *(const f32x4*)(gfin + col0 + bj * HALF); gv[bj][1] = *(const f32x4*)(gfin + col0 + bj * HALF + 4); }
#pragma unroll
        for (int ai = 0; ai < 2; ++ai)
#pragma unroll
            for (int m = 0; m < 4; ++m) { const int rl = wr * 64 + fr + ai * HALF + m * 16; const float sr = S[rl];
#pragma unroll
                for (int bj = 0; bj < 2; ++bj) { const size_t off = (size_t)(u.pm * BM + rl) * DM + col0 + bj * HALF;
                    *(f32x4*)(OUT + off) = acc[ai][bj][m][0] * sr * gv[bj][0]; *(f32x4*)(OUT + off + 4) = acc[ai][bj][m][1] * sr * gv[bj][1]; } }
    }
};
}

__device__ __forceinline__ int map_col(int mode, int n) {
    if (mode == 0) return n;
    if (mode == 1) {
        if (n < FF) return 256 * (n >> 7) + (n & 127);
        const int q = n - FF; return 256 * (q >> 7) + 128 + (q & 127);
    }
    if (n < 3072) return n;
    if (n < 3088) return 6848 + (n - 3072);
    if (n < 4112) return 3072 + (n - 3088);
    if (n < 4240) return 6656 + (n - 4112);
    if (n < 4752) return 4096 + (n - 4240);
    if (n < 4816) return 6784 + (n - 4752);
    if (n < 4824) return 6864 + (n - 4816);
    return 4608 + (n - 4824);
}
__device__ __forceinline__ void transpose_item(const float* W, int K, int N, bf16_t* WT, const float* gain, int mode, LAS float* scr, int item, int lane) {
    const int nblk = (N + 31) / 32, kb = item / nblk, nb = item % nblk, k0 = 64 * kb, n0 = 32 * nb;
    const int nn = n0 + (lane & 31);
    float v[32];
    const float* wp = W + (size_t)(k0 + (lane >> 5)) * N + nn;
#pragma unroll
    for (int i = 0; i < 32; ++i) v[i] = (nn < N) ? wp[(size_t)(2 * i) * N] : 0.f;
#pragma unroll
    for (int i = 0; i < 32; ++i) scr[(2 * i + (lane >> 5)) * 33 + (lane & 31)] = v[i];
    asm volatile("s_waitcnt lgkmcnt(0)" ::: "memory");
    const int c = lane & 7;
    f32x4 g0 = (f32x4){1.f, 1.f, 1.f, 1.f}, g1 = g0;
    if (gain) { g0 = *(const f32x4*)(gain + k0 + 8 * c); g1 = *(const f32x4*)(gain + k0 + 8 * c + 4); }
#pragma unroll
    for (int j = 0; j < 4; ++j) { const int nl = (lane >> 3) + 8 * j; const int n = n0 + nl; const LAS float* s = scr + (8 * c) * 33 + nl;
        u32x4 o; o.x = pg8::cvt_pk_bf16(s[0 * 33] * g0[0], s[1 * 33] * g0[1]); o.y = pg8::cvt_pk_bf16(s[2 * 33] * g0[2], s[3 * 33] * g0[3]);
        o.z = pg8::cvt_pk_bf16(s[4 * 33] * g1[0], s[5 * 33] * g1[1]); o.w = pg8::cvt_pk_bf16(s[6 * 33] * g1[2], s[7 * 33] * g1[3]);
        if (n < N) *(u32x4*)(WT + (size_t)map_col(mode, n) * K + k0 + 8 * c) = o; }
    asm volatile("s_waitcnt lgkmcnt(0)" ::: "memory");
}

typedef short v4i16_t __attribute__((ext_vector_type(4)));
__device__ __forceinline__ float logsigmoidf_(float x) { return fminf(x, 0.f) - __logf(1.0f + __expf(-fabsf(x))); }
__device__ __forceinline__ int swz(int r) { return ((r & 3) << 2) | ((r >> 2) & 3); }
__device__ __forceinline__ int swzd(int r) { return (((r & 7) ^ ((r >> 1) & 4)) << 1) | ((r >> 3) & 1); }

constexpr int GP_GAL = 0, GP_TOT = 8192;
__device__ __forceinline__ void gla_prep_item(int b, int h, int np, unsigned char* ws, const float* alpha_w, const float* alpha_b, float* DECG, unsigned* cnt, LAS unsigned char* lds, const int w) {
    const int lane = lane_id(), tid = w * 64 + lane;
    bf16_t* GQ = (bf16_t*)(ws + WS_GQ); bf16_t* GK = (bf16_t*)(ws + WS_GK); const float* GA = (const float*)(ws + WS_GA);
    LAS float* GAL = (LAS float*)(lds + GP_GAL); LAS float* TOT = (LAS float*)(lds + GP_TOT);
    const int m0 = b * SEQ + np * 128, d0 = 2 * lane;
#pragma unroll
    for (int c = 0; c < 2; ++c) { const f32x2 v = *(const f32x2*)(GA + (size_t)m0 * 16 + c * 1024 + tid * 2); *(LAS f32x2*)(GAL + c * 1024 + tid * 2) = v; }
    float aw0[16], aw1[16];
#pragma unroll
    for (int r = 0; r < 16; ++r) { const f32x2 a = *(const f32x2*)(alpha_w + r * 512 + h * 128 + d0); aw0[r] = a[0]; aw1[r] = a[1]; }
    const f32x2 ab = *(const f32x2*)(alpha_b + h * 128 + d0);
    unsigned qw[2][8], kw[2][8];
#pragma unroll
    for (int c = 0; c < 2; ++c)
#pragma unroll
        for (int ii = 0; ii < 8; ++ii) { const size_t o = (size_t)(m0 + 64 * c + 8 * w + ii) * 512 + h * 128 + d0; qw[c][ii] = *(const unsigned*)(GQ + o); kw[c][ii] = *(const unsigned*)(GK + o); }
    __syncthreads();
    float bl0[2][8], bl1[2][8];
#pragma unroll
    for (int c = 0; c < 2; ++c) { float run0 = 0.f, run1 = 0.f;
#pragma unroll
        for (int ii = 0; ii < 8; ++ii) { const int i = 64 * c + 8 * w + ii; float x0 = ab[0], x1 = ab[1];
#pragma unroll
            for (int r4 = 0; r4 < 4; ++r4) { const f32x4 gq = *(const LAS f32x4*)(GAL + i * 16 + 4 * r4);
#pragma unroll
                for (int j = 0; j < 4; ++j) { x0 += gq[j] * aw0[4 * r4 + j]; x1 += gq[j] * aw1[4 * r4 + j]; } }
            run0 += logsigmoidf_(x0) * (1.0f / 16.0f); run1 += logsigmoidf_(x1) * (1.0f / 16.0f); bl0[c][ii] = run0; bl1[c][ii] = run1; }
        *(LAS f32x2*)(TOT + c * 1024 + w * 128 + d0) = (f32x2){run0, run1}; }
    __syncthreads();
#pragma unroll
    for (int c = 0; c < 2; ++c) {
        float off0 = 0.f, off1 = 0.f, bt0 = 0.f, bt1 = 0.f;
#pragma unroll
        for (int r = 0; r < 8; ++r) { const f32x2 t = *(const LAS f32x2*)(TOT + c * 1024 + r * 128 + d0); bt0 += t[0]; bt1 += t[1]; if (r < w) { off0 += t[0]; off1 += t[1]; } }
        if (w == 0) *(f32x2*)(DECG + ((size_t)((b * 4 + h) * 32 + 2 * np + c)) * 128 + d0) = (f32x2){__expf(bt0), __expf(bt1)};
#pragma unroll
        for (int ii = 0; ii < 8; ++ii) { const size_t o = (size_t)(m0 + 64 * c + 8 * w + ii) * 512 + h * 128 + d0;
            const float b0 = off0 + bl0[c][ii], b1 = off1 + bl1[c][ii];
            *(unsigned*)(GQ + o) = pk2(bflo(qw[c][ii]) * __expf(b0), bfhi(qw[c][ii]) * __expf(b1));
            *(unsigned*)(GK + o) = pk2(bflo(kw[c][ii]) * __expf(-b0), bfhi(kw[c][ii]) * __expf(-b1)); }
    }
    asm volatile("s_waitcnt vmcnt(0)" ::: "memory");
    __syncthreads();
    if (w == 0 && lane == 0) { __builtin_amdgcn_fence(__ATOMIC_RELEASE, "agent"); asm volatile("s_waitcnt vmcnt(0)" ::: "memory");
        __hip_atomic_fetch_add(cnt + 64 * (b * 4 + h), 2u, __ATOMIC_RELAXED, __HIP_MEMORY_SCOPE_AGENT); }
}

constexpr int GL_BUF = 65536, GL_QI = 0, GL_KI = 16384, GL_VI = 32768, GL_PL = 131072, GL_SS = 131072 + 9216, GL_DEC = 131072 + 9216 + 2048;
template <bool WITHQ> __device__ __forceinline__ void gla_issue_chunk(const unsigned char* ws, int b, int h, int n, LAS unsigned char* buf, int w, int g, int l15) {
    const size_t m0 = (size_t)(b * SEQ + n * 64);
    const unsigned char* qb = ws + WS_GQ + (m0 * 512 + h * 128) * 2;
    const unsigned char* kb = ws + WS_GK + (m0 * 512 + h * 128) * 2;
    const unsigned char* vb = ws + WS_GV + (m0 * 1024 + h * 256) * 2;
#pragma unroll
    for (int jj = 0; jj < 2; ++jj) { const int j = 2 * w + jj; const unsigned off = (unsigned)((4 * j + g) * 1024 + ((l15 ^ ((g << 2) | (j & 3))) << 4));
        if (WITHQ) glds16_asm(qb + off, (unsigned)__builtin_amdgcn_readfirstlane((int)LDS_ADDR(buf + GL_QI + 1024 * j)));
        glds16_asm(kb + off, (unsigned)__builtin_amdgcn_readfirstlane((int)LDS_ADDR(buf + GL_KI + 1024 * j))); }
#pragma unroll
    for (int jj = 0; jj < 4; ++jj) { const int pv = 4 * w + jj, hv = pv >> 4, j = pv & 15; const unsigned off = (unsigned)((4 * j + g) * 2048 + hv * 256 + ((l15 ^ ((g << 2) | (j & 3))) << 4));
        glds16_asm(vb + off, (unsigned)__builtin_amdgcn_readfirstlane((int)LDS_ADDR(buf + GL_VI + 16384 * hv + 1024 * j))); }
}
template <bool FULL> __device__ __forceinline__ void gla_item(int b, int h, int n0, int n1, int init, int seg, unsigned char* ws, const float* gnorm, const float* DECG, float* STATE, unsigned* cnt, unsigned* stflag, unsigned* tmo, LAS unsigned char* lds, const int w) {
    bf16_t* GV = (bf16_t*)(ws + WS_GV); const bf16_t* GR = (const bf16_t*)(ws + WS_GR);
    LAS unsigned char* PL = lds + GL_PL; LAS float* SS = (LAS float*)(lds + GL_SS); LAS float* DEC = (LAS float*)(lds + GL_DEC);
    const float* decg = DECG + (size_t)((b * 4 + h) * 32) * 128;
    if (w == 0) { unsigned sp = 0; const int lane = lane_id();
        while ((unsigned)__builtin_amdgcn_readfirstlane(__hip_atomic_load(cnt + 64 * (b * 4 + h), __ATOMIC_RELAXED, __HIP_MEMORY_SCOPE_AGENT)) < 32u) {
            __builtin_amdgcn_s_sleep(4); if (++sp > (1u << 22)) { if (lane == 0) atomicAdd(tmo, 1u); break; } }
        if (FULL) for (int k = 0; k < (init == 0 ? 1 : 2); ++k) {
            while ((unsigned)__builtin_amdgcn_readfirstlane(__hip_atomic_load(stflag + 64 * ((b * 4 + h) * 2 + k), __ATOMIC_RELAXED, __HIP_MEMORY_SCOPE_AGENT)) == 0u) {
                __builtin_amdgcn_s_sleep(4); if (++sp > (1u << 22)) { if (lane == 0) atomicAdd(tmo, 1u); break; } } }
        __builtin_amdgcn_fence(__ATOMIC_ACQUIRE, "agent"); asm volatile("s_waitcnt vmcnt(0)" ::: "memory"); }
    __syncthreads();
    f32x4 gn[2];
    { const int g = lane_id() >> 4;
#pragma unroll
    for (int et = 0; et < 2; ++et) gn[et] = *(const f32x4*)(gnorm + h * 256 + 32 * w + 16 * et + 4 * g); }
    f32x4 Sacc[8][2];
    float* const st0 = STATE + ((size_t)(((b * 4 + h) * 2 + 0) * 8 + w) * 16) * 256;
    float* const st1 = STATE + ((size_t)(((b * 4 + h) * 2 + 1) * 8 + w) * 16) * 256;
    { const int lane = lane_id(), g = lane >> 4;
#pragma unroll
      for (int dt = 0; dt < 8; ++dt)
#pragma unroll
        for (int et = 0; et < 2; ++et) {
            f32x4 v = (f32x4){0.f, 0.f, 0.f, 0.f};
            if (FULL && init >= 1) v = *(const f32x4*)(st0 + (dt * 2 + et) * 256 + lane * 4);
            Sacc[dt][et] = v; }
      if (FULL && init == 2) {
#pragma unroll
        for (int dt = 0; dt < 8; ++dt) { f32x4 d1 = (f32x4){1.f, 1.f, 1.f, 1.f};
            for (int n = 11; n < 22; ++n) d1 = d1 * *(const f32x4*)(decg + n * 128 + 16 * dt + 4 * g);
#pragma unroll
            for (int et = 0; et < 2; ++et) Sacc[dt][et] = Sacc[dt][et] * d1 + *(const f32x4*)(st1 + (dt * 2 + et) * 256 + lane * 4); } }
      gla_issue_chunk<FULL>(ws, b, h, n0, lds, w, lane >> 4, lane & 15);
      if (w < 2) glds4_asm(decg + n0 * 128 + w * 64 + lane, (unsigned)__builtin_amdgcn_readfirstlane((int)LDS_ADDR(DEC + w * 64))); }
    const int hv = w >> 2;
    u32x2 pend[2][4]; int pend_m0 = -1;
#pragma unroll
    for (int et = 0; et < 2; ++et)
#pragma unroll
        for (int it = 0; it < 4; ++it) pend[et][it] = (u32x2){0u, 0u};
    asm volatile("s_waitcnt vmcnt(0)" ::: "memory");
    for (int n = n0; n < n1; ++n) {
        const int m0 = b * SEQ + n * 64, cur = (n - n0) & 1;
        const int lane = lane_id(), tid = w * 64 + lane, l15 = lane & 15, g = lane >> 4, qq = l15 >> 2, pp = l15 & 3;
        LAS unsigned char* buf = lds + cur * GL_BUF;
        LAS unsigned char* QI = buf + GL_QI; LAS unsigned char* KI = buf + GL_KI; LAS unsigned char* VI = buf + GL_VI + 16384 * hv;
        asm volatile("s_waitcnt vmcnt(0) lgkmcnt(0)" ::: "memory");
        __builtin_amdgcn_s_barrier(); asm volatile("" ::: "memory");
        if constexpr (FULL) { if (pend_m0 >= 0) {
#pragma unroll
            for (int it = 0; it < 4; ++it)
#pragma unroll
                for (int et = 0; et < 2; ++et) *(u32x2*)((unsigned char*)GV + ((size_t)pend_m0 * 1024 + h * 256 + 32 * w) * 2 + (unsigned)((16 * it + l15) * 2048 + (16 * et + 4 * g) * 2)) = pend[et][it]; } }
        if (n + 1 < n1) { gla_issue_chunk<FULL>(ws, b, h, n + 1, lds + (cur ^ 1) * GL_BUF, w, g, l15);
            if (w < 2) glds4_asm(decg + (n + 1) * 128 + w * 64 + lane, (unsigned)__builtin_amdgcn_readfirstlane((int)LDS_ADDR(DEC + (cur ^ 1) * 128 + w * 64))); }
        u32x2 grw[2][4];
        if constexpr (FULL) {
#pragma unroll
        for (int et = 0; et < 2; ++et)
#pragma unroll
            for (int it = 0; it < 4; ++it) grw[et][it] = *(const u32x2*)((const unsigned char*)GR + ((size_t)m0 * 1024 + h * 256 + 32 * w) * 2 + (unsigned)((16 * it + l15) * 2048 + (16 * et + 4 * g) * 2));
#pragma unroll
        for (int tt2 = 0; tt2 < 2; ++tt2) { const int tt = 2 * w + tt2, it = tt >> 2, jt = tt & 3;
            f32x4 pacc = (f32x4){0.f, 0.f, 0.f, 0.f};
            if (jt <= it) { const int rk = 16 * jt + l15, rq = 16 * it + l15; const int xk = swz(rk), xq = swz(rq);
#pragma unroll
                for (int s = 0; s < 4; ++s) { const bf16x8 a = *(const LAS bf16x8*)(KI + 256 * rk + 16 * ((4 * s + g) ^ xk)), bq = *(const LAS bf16x8*)(QI + 256 * rq + 16 * ((4 * s + g) ^ xq));
                    pacc = __builtin_amdgcn_mfma_f32_16x16x32_bf16(a, bq, pacc, 0, 0, 0); }
            }
            const int i = 16 * it + l15; float pv[4];
#pragma unroll
            for (int r = 0; r < 4; ++r) { const int j = 16 * jt + 4 * g + r; pv[r] = (j <= i) ? pacc[r] : 0.f; }
            u32x2 o; o.x = pg8::cvt_pk_bf16(pv[0], pv[1]); o.y = pg8::cvt_pk_bf16(pv[2], pv[3]);
            *(LAS u32x2*)(PL + 144 * i + 2 * (16 * jt + 4 * g)) = o; }
        asm volatile("s_waitcnt lgkmcnt(0)" ::: "memory"); __builtin_amdgcn_s_barrier(); asm volatile("" ::: "memory");
        }
#define GL_TR2(dst, base, ra_, ch_) do { const int ra__ = (ra_), rb__ = ra__ + 4; \
            const v4i16_t x_ = __builtin_amdgcn_ds_read_tr16_b64_v4i16((LAS v4i16_t*)((base) + 256 * ra__ + 16 * ((ch_) ^ swz(ra__)) + 8 * (pp & 1))); \
            const v4i16_t y_ = __builtin_amdgcn_ds_read_tr16_b64_v4i16((LAS v4i16_t*)((base) + 256 * rb__ + 16 * ((ch_) ^ swz(rb__)) + 8 * (pp & 1))); \
            dst = (bf16x8){x_[0], x_[1], x_[2], x_[3], y_[0], y_[1], y_[2], y_[3]}; } while (0)
#define GL_LDQ(dst, s_) do { _Pragma("unroll") for (int it = 0; it < 4; ++it) { const int i = 16 * it + l15, xi = swz(i); \
            const u32x2 lo = *(const LAS u32x2*)(QI + 256 * i + 16 * ((4 * (s_) + (g >> 1)) ^ xi) + 8 * (g & 1)), hi = *(const LAS u32x2*)(QI + 256 * i + 16 * ((4 * (s_) + 2 + (g >> 1)) ^ xi) + 8 * (g & 1)); \
            u32x4 t; t.x = lo.x; t.y = lo.y; t.z = hi.x; t.w = hi.y; dst[it] = __builtin_bit_cast(bf16x8, t); } } while (0)
#define GL_SQ(src, s_) do { _Pragma("unroll") for (int et = 0; et < 2; ++et) { u32x4 t; const f32x4 s0 = Sacc[2 * (s_)][et], s1 = Sacc[2 * (s_) + 1][et]; \
            t.x = pg8::cvt_pk_bf16(s0[0], s0[1]); t.y = pg8::cvt_pk_bf16(s0[2], s0[3]); t.z = pg8::cvt_pk_bf16(s1[0], s1[1]); t.w = pg8::cvt_pk_bf16(s1[2], s1[3]); \
            const bf16x8 sf = __builtin_bit_cast(bf16x8, t); \
            _Pragma("unroll") for (int it = 0; it < 4; ++it) oacc[et][it] = __builtin_amdgcn_mfma_f32_16x16x32_bf16(sf, src[it], oacc[et][it], 0, 0, 0); } } while (0)
        bf16x8 vf[2][2];
#pragma unroll
        for (int et = 0; et < 2; ++et)
#pragma unroll
            for (int s = 0; s < 2; ++s) GL_TR2(vf[et][s], VI, 32 * s + 8 * g + qq, 2 * (2 * (w & 3) + et) + (pp >> 1));
        f32x4 oacc[2][4];
#pragma unroll
        for (int et = 0; et < 2; ++et)
#pragma unroll
            for (int it = 0; it < 4; ++it) oacc[et][it] = (f32x4){0.f, 0.f, 0.f, 0.f};
#define GL_SU(src, s_, d0_) do { _Pragma("unroll") for (int dt = 0; dt < 4; ++dt) _Pragma("unroll") for (int et = 0; et < 2; ++et) \
                Sacc[(d0_) + dt][et] = __builtin_amdgcn_mfma_f32_16x16x32_bf16(src[dt], vf[et][s_], Sacc[(d0_) + dt][et], 0, 0, 0); } while (0)
        {
            bf16x8 ka[4], kb[4];
            if constexpr (FULL) {
                bf16x8 qa[4], qb[4];
                GL_LDQ(qa, 0); GL_LDQ(qb, 1);
                GL_SQ(qa, 0); GL_LDQ(qa, 2);
                GL_SQ(qb, 1); GL_LDQ(qb, 3);
                bf16x8 pf0[4], pf1[4];
#pragma unroll
                for (int it = 0; it < 4; ++it) pf0[it] = *(const LAS bf16x8*)(PL + 144 * (16 * it + l15) + 16 * g);
                GL_SQ(qa, 2);
#pragma unroll
                for (int it = 0; it < 4; ++it) pf1[it] = *(const LAS bf16x8*)(PL + 144 * (16 * it + l15) + 64 + 16 * g);
                GL_SQ(qb, 3);
#pragma unroll
                for (int dt = 0; dt < 4; ++dt) GL_TR2(ka[dt], KI, 8 * g + qq, 2 * dt + (pp >> 1));
#pragma unroll
                for (int et = 0; et < 2; ++et)
#pragma unroll
                    for (int it = 0; it < 4; ++it) oacc[et][it] = __builtin_amdgcn_mfma_f32_16x16x32_bf16(vf[et][0], pf0[it], oacc[et][it], 0, 0, 0);
#pragma unroll
                for (int dt = 0; dt < 4; ++dt) GL_TR2(kb[dt], KI, 8 * g + qq, 2 * (dt + 4) + (pp >> 1));
#pragma unroll
                for (int et = 0; et < 2; ++et)
#pragma unroll
                    for (int it = 0; it < 4; ++it) oacc[et][it] = __builtin_amdgcn_mfma_f32_16x16x32_bf16(vf[et][1], pf1[it], oacc[et][it], 0, 0, 0);
            } else {
#pragma unroll
                for (int dt = 0; dt < 4; ++dt) GL_TR2(ka[dt], KI, 8 * g + qq, 2 * dt + (pp >> 1));
#pragma unroll
                for (int dt = 0; dt < 4; ++dt) GL_TR2(kb[dt], KI, 8 * g + qq, 2 * (dt + 4) + (pp >> 1));
            }
            GL_SU(ka, 0, 0);
#pragma unroll
            for (int dt = 0; dt < 4; ++dt) GL_TR2(ka[dt], KI, 32 + 8 * g + qq, 2 * dt + (pp >> 1));
            GL_SU(kb, 0, 4);
#pragma unroll
            for (int dt = 0; dt < 4; ++dt) GL_TR2(kb[dt], KI, 32 + 8 * g + qq, 2 * (dt + 4) + (pp >> 1));
            GL_SU(ka, 1, 0);
            GL_SU(kb, 1, 4);
        }
#undef GL_TR2
#undef GL_LDQ
#undef GL_SQ
#undef GL_SU
#pragma unroll
        for (int dt = 0; dt < 8; ++dt) { const f32x4 d4 = *(const LAS f32x4*)(DEC + cur * 128 + 16 * dt + 4 * g);
#pragma unroll
            for (int et = 0; et < 2; ++et) Sacc[dt][et] = Sacc[dt][et] * d4; }
        if constexpr (FULL) {
        {
            float ssq[4];
#pragma unroll
            for (int it = 0; it < 4; ++it) { float s = 0.f;
#pragma unroll
                for (int et = 0; et < 2; ++et) { const f32x4 o = oacc[et][it]; s += (o[0] * o[0] + o[1] * o[1]) + (o[2] * o[2] + o[3] * o[3]); }
                s = rows4_sum(s); ssq[it] = s; }
            if (g == 0) {
#pragma unroll
                for (int it = 0; it < 4; ++it) SS[w * 64 + 16 * it + l15] = ssq[it]; }
        }
        asm volatile("s_waitcnt lgkmcnt(0)" ::: "memory"); __builtin_amdgcn_s_barrier(); asm volatile("" ::: "memory");
#pragma unroll
        for (int it = 0; it < 4; ++it) { const int i = 16 * it + l15; float tot = 0.f;
#pragma unroll
            for (int ww = 0; ww < 8; ++ww) tot += SS[ww * 64 + i];
            const float rstd = __builtin_amdgcn_rsqf(tot * (1.0f / 256.0f) + EPS);
#pragma unroll
            for (int et = 0; et < 2; ++et) {
                const u32x2 gw = grw[et][it];
                const f32x4 o = oacc[et][it];
                const float v0 = o[0] * rstd * gn[et][0] * siluf_(bflo(gw.x)), v1 = o[1] * rstd * gn[et][1] * siluf_(bfhi(gw.x));
                const float v2 = o[2] * rstd * gn[et][2] * siluf_(bflo(gw.y)), v3 = o[3] * rstd * gn[et][3] * siluf_(bfhi(gw.y));
                u32x2 ow; ow.x = pg8::cvt_pk_bf16(v0, v1); ow.y = pg8::cvt_pk_bf16(v2, v3);
                pend[et][it] = ow; }
        }
        pend_m0 = m0;
        }
    }
    if constexpr (FULL) { if (pend_m0 >= 0) { const int lane = lane_id(), l15 = lane & 15, g = lane >> 4;
#pragma unroll
        for (int it = 0; it < 4; ++it)
#pragma unroll
            for (int et = 0; et < 2; ++et) *(u32x2*)((unsigned char*)GV + ((size_t)pend_m0 * 1024 + h * 256 + 32 * w) * 2 + (unsigned)((16 * it + l15) * 2048 + (16 * et + 4 * g) * 2)) = pend[et][it]; } }
    if constexpr (!FULL) {
        const int lane = lane_id();
        float* const so = seg ? st1 : st0;
#pragma unroll
        for (int dt = 0; dt < 8; ++dt)
#pragma unroll
            for (int et = 0; et < 2; ++et) *(f32x4*)(so + (dt * 2 + et) * 256 + lane * 4) = Sacc[dt][et];
        asm volatile("s_waitcnt vmcnt(0)" ::: "memory");
        __syncthreads();
        if (w == 0 && lane == 0) { __builtin_amdgcn_fence(__ATOMIC_RELEASE, "agent"); asm volatile("s_waitcnt vmcnt(0)" ::: "memory");
            __hip_atomic_store(stflag + 64 * ((b * 4 + h) * 2 + seg), 1u, __ATOMIC_RELAXED, __HIP_MEMORY_SCOPE_AGENT); }
    }
    asm volatile("s_waitcnt vmcnt(0) lgkmcnt(0)" ::: "memory");
    __syncthreads();
}

template <int V> struct IConst { static constexpr int value = V; };
constexpr int DS_SC = 0, DS_SEL = 131072, DS_CNT = 131072 + 8192, DS_RB = 143360;
__device__ __forceinline__ int t5_bucket(int d) {
    if (d < 16) return d;
    const int large = 16 + (int)(__logf((float)d * (1.0f / 16.0f)) * (16.0f / 2.0794415416798357f));
    return large < 31 ? large : 31;
}
__device__ __forceinline__ void dsa_item(int b, int qt, unsigned char* ws, const float* rel_bias, LAS unsigned char* lds, const int w) {
    const int lane = lane_id(), tid = w * 64 + lane, l15 = lane & 15, g = lane >> 4;
    const bf16_t* IQ = (const bf16_t*)(ws + WS_IQ); const bf16_t* IK = (const bf16_t*)(ws + WS_IK); const float* IW = (const float*)(ws + WS_IW);
    const bf16_t* CKV = (const bf16_t*)(ws + WS_CKV); bf16_t* DQ = (bf16_t*)(ws + WS_DQ);
    LAS float* SC = (LAS float*)(lds + DS_SC); LAS unsigned short* SEL = (LAS unsigned short*)(lds + DS_SEL); LAS int* CNT = (LAS int*)(lds + DS_CNT);
    const int mb = b * SEQ, t0 = 16 * qt;
    {
        bf16x8 af[8][2];
#pragma unroll
        for (int hh = 0; hh < 8; ++hh)
#pragma unroll
            for (int ks = 0; ks < 2; ++ks) af[hh][ks] = *(const bf16x8*)(IQ + (size_t)(mb + t0 + l15) * 512 + hh * 64 + 32 * ks + 8 * g);
        float wg[4][8];
#pragma unroll
        for (int r = 0; r < 4; ++r) { const f32x4 a = *(const f32x4*)(IW + (size_t)(mb + t0 + 4 * g + r) * 8), c = *(const f32x4*)(IW + (size_t)(mb + t0 + 4 * g + r) * 8 + 4);
#pragma unroll
            for (int j = 0; j < 4; ++j) { wg[r][j] = a[j] * 0.04419417382415922f; wg[r][4 + j] = c[j] * 0.04419417382415922f; } }
        const bf16_t* ikp = IK + (size_t)(mb + l15) * 64 + 8 * g;
#define DS_LDK(d0, d1, kt_) do { if ((kt_) <= qt) { d0 = *(const bf16x8*)(ikp + (size_t)(16 * (kt_)) * 64); d1 = *(const bf16x8*)(ikp + (size_t)(16 * (kt_)) * 64 + 32); } } while (0)
#define DS_TILE(b0, b1, kt_) do { if ((kt_) <= qt) { float sc[4] = {0.f, 0.f, 0.f, 0.f}; \
            _Pragma("unroll") for (int hh = 0; hh < 8; ++hh) { f32x4 a = (f32x4){0.f, 0.f, 0.f, 0.f}; \
                a = __builtin_amdgcn_mfma_f32_16x16x32_bf16(af[hh][0], b0, a, 0, 0, 0); a = __builtin_amdgcn_mfma_f32_16x16x32_bf16(af[hh][1], b1, a, 0, 0, 0); \
                _Pragma("unroll") for (int r = 0; r < 4; ++r) { const float af_ = a[r]; const int ab_ = __float_as_int(af_); sc[r] += wg[r][hh] * __int_as_float(ab_ > 0 ? ab_ : 0); } } \
            _Pragma("unroll") for (int r = 0; r < 4; ++r) SC[(4 * g + r) * 2048 + 16 * (kt_) + l15] = sc[r]; } } while (0)
        bf16x8 ka0 = (bf16x8){0, 0, 0, 0, 0, 0, 0, 0}, ka1 = ka0, kb0 = ka0, kb1 = ka0, kc0 = ka0, kc1 = ka0;
        DS_LDK(ka0, ka1, w); DS_LDK(kb0, kb1, w + 8); DS_LDK(kc0, kc1, w + 16);
        for (int kt = w; kt <= qt; kt += 24) {
            { const bf16x8 x0 = ka0, x1 = ka1; DS_LDK(ka0, ka1, kt + 24); DS_TILE(x0, x1, kt); }
            { const bf16x8 x0 = kb0, x1 = kb1; DS_LDK(kb0, kb1, kt + 32); DS_TILE(x0, x1, kt + 8); }
            { const bf16x8 x0 = kc0, x1 = kc1; DS_LDK(kc0, kc1, kt + 40); DS_TILE(x0, x1, kt + 16); }
        }
#undef DS_LDK
#undef DS_TILE
    }
    __syncthreads();
    for (int ph = 0; ph < 4; ++ph) {
      const int isS3 = (w < 4) ? (ph & 1) : (ph >> 1);
      const int q2 = (w < 4) ? (ph >> 1) : (ph & 1);
      if (!isS3) {
            const int tt = 2 * w + q2, t = t0 + tt, n = t + 1;
            LAS unsigned short* sel = SEL + tt * 256;
            if (n <= 256) {
                for (int k = lane; k < 256; k += 64) sel[k] = (unsigned short)(k < n ? k : 0);
                if (lane == 0) CNT[tt] = n;
            } else {
                const int nb8 = (n + 255) >> 8;
                float val[32];
#pragma unroll
                for (int i = 0; i < 32; ++i) val[i] = SC[tt * 2048 + lane + 64 * i];
#pragma unroll
                for (int i = 0; i < 32; ++i) val[i] = (lane + 64 * i < n) ? val[i] : -__builtin_inff();
                float lo = 0.f, hi = 0.f, piv = 0.f; bool found = false; int tie_need = 0;
                { int g0 = 0, g1 = 0, g2 = 0, g3 = 0;
#pragma unroll
                  for (int i8 = 0; i8 < 8; ++i8) if (i8 < nb8) { g0 += (val[4 * i8] > 0.f) ? 1 : 0; g1 += (val[4 * i8 + 1] > 0.f) ? 1 : 0; g2 += (val[4 * i8 + 2] > 0.f) ? 1 : 0; g3 += (val[4 * i8 + 3] > 0.f) ? 1 : 0; }
                  const int cgt0 = wave_isum((g0 + g1) + (g2 + g3));
                  if (cgt0 == 256) { found = true; }
                  else if (cgt0 > 256) {
                      int m0 = 0, m1 = 0;
#pragma unroll
                      for (int i = 0; i < 32; i += 4) { m0 = max(max(m0, __float_as_int(val[i])), __float_as_int(val[i + 1])); m1 = max(max(m1, __float_as_int(val[i + 2])), __float_as_int(val[i + 3])); }
                      hi = __int_as_float(wave_imax(max(m0, m1)));
                  } else {
                      int e0 = 0, e1 = 0, e2 = 0, e3 = 0;
#pragma unroll
                      for (int i8 = 0; i8 < 8; ++i8) if (i8 < nb8) { e0 += (val[4 * i8] >= 0.f) ? 1 : 0; e1 += (val[4 * i8 + 1] >= 0.f) ? 1 : 0; e2 += (val[4 * i8 + 2] >= 0.f) ? 1 : 0; e3 += (val[4 * i8 + 3] >= 0.f) ? 1 : 0; }
                      const int cge0 = wave_isum((e0 + e1) + (e2 + e3));
                      if (cge0 >= 256) { found = true; tie_need = 256 - cgt0; }
                      else {
                          unsigned m0 = 0u, m1 = 0u;
#pragma unroll
                          for (int i = 0; i < 32; i += 2) { m0 = max(m0, (lane + 64 * i < n) ? __float_as_uint(val[i]) : 0u); m1 = max(m1, (lane + 64 * (i + 1) < n) ? __float_as_uint(val[i + 1]) : 0u); }
                          lo = __uint_as_float(wave_umax(max(m0, m1)));
                      }
                  } }
                auto bisect = [&](auto NBC) __attribute__((always_inline)) {
                    constexpr int NB = decltype(NBC)::value;
                    for (int itn = 0; itn < 40 && !found; ++itn) {
                        const float mid = 0.5f * lo + 0.5f * hi;
                        if (!(mid > lo) || !(mid < hi)) break;
                        int lc0 = 0, lc1 = 0, lc2 = 0, lc3 = 0;
#pragma unroll
                        for (int i8 = 0; i8 < NB; ++i8) { lc0 += (val[4 * i8] > mid) ? 1 : 0; lc1 += (val[4 * i8 + 1] > mid) ? 1 : 0; lc2 += (val[4 * i8 + 2] > mid) ? 1 : 0; lc3 += (val[4 * i8 + 3] > mid) ? 1 : 0; }
                        const int cnt = wave_isum((lc0 + lc1) + (lc2 + lc3));
                        if (cnt == 256) { piv = mid; found = true; break; }
                        if (cnt > 256) lo = mid; else hi = mid;
                    } };
                switch (nb8) { case 2: bisect(IConst<2>{}); break; case 3: bisect(IConst<3>{}); break; case 4: bisect(IConst<4>{}); break; case 5: bisect(IConst<5>{}); break;
                               case 6: bisect(IConst<6>{}); break; case 7: bisect(IConst<7>{}); break; default: bisect(IConst<8>{}); break; }
                if (found && tie_need > 0) {
                    const unsigned long long lt = (1ull << lane) - 1ull;
                    int pos = 0, eqs = 0;
#pragma unroll
                    for (int i8 = 0; i8 < 8; ++i8) if (i8 < nb8) {
#pragma unroll
                        for (int i = 0; i < 4; ++i) {
                            const float kv = val[4 * i8 + i];
                            const bool gt = kv > 0.f, eq = kv == 0.f;
                            const unsigned long long meq = __ballot(eq);
                            const bool take = gt || (eq && (eqs + __builtin_popcountll(meq & lt)) < tie_need);
                            const unsigned long long mt = __ballot(take);
                            if (take) sel[pos + __builtin_popcountll(mt & lt)] = (unsigned short)(lane + 64 * (4 * i8 + i));
                            pos += __builtin_popcountll(mt); eqs += __builtin_popcountll(meq);
                        } }
                } else
                if (found) {
                    int pos = 0;
                    LAS unsigned short* const dummy = (LAS unsigned short*)(lds + DS_CNT + 64) + lane;
#pragma unroll
                    for (int i = 0; i < 32; ++i) {
                        const bool take = val[i] > piv;
                        const unsigned long long m = __ballot(take);
                        const int p = pos + (int)__builtin_amdgcn_mbcnt_hi((unsigned)(m >> 32), __builtin_amdgcn_mbcnt_lo((unsigned)m, 0u));
                        LAS unsigned short* const dst = take ? (sel + p) : dummy;
                        *dst = (unsigned short)(lane + 64 * i);
                        pos += __builtin_popcountll(m);
                    }
                } else {
                unsigned key[32];
#pragma unroll
                for (int i = 0; i < 32; ++i) { const unsigned u = __builtin_bit_cast(unsigned, val[i]); key[i] = (u & 0x80000000u) ? ~u : (u | 0x80000000u); }
                unsigned T = 0u;
                for (int bit = 31; bit >= 0; --bit) {
                    const unsigned cand = T | (1u << bit); int lc = 0;
#pragma unroll
                    for (int i8 = 0; i8 < 8; ++i8) if (i8 < nb8) {
#pragma unroll
                        for (int i = 0; i < 4; ++i) lc += (key[4 * i8 + i] >= cand) ? 1 : 0; }
                    const int cnt = wave_isum(lc);
                    if (cnt >= 256) { T = cand; if (cnt == 256) break; }
                }
                int lg_ = 0;
#pragma unroll
                for (int i8 = 0; i8 < 8; ++i8) if (i8 < nb8) {
#pragma unroll
                    for (int i = 0; i < 4; ++i) lg_ += (key[4 * i8 + i] > T) ? 1 : 0; }
                const int cgt = wave_isum(lg_);
                const int need = 256 - cgt;
                const unsigned long long lt = (1ull << lane) - 1ull;
                int pos = 0, eqs = 0;
#pragma unroll
                for (int i8 = 0; i8 < 8; ++i8) if (i8 < nb8) {
#pragma unroll
                    for (int i = 0; i < 4; ++i) {
                        const unsigned kv = key[4 * i8 + i];
                        const bool gt = kv > T, eq = kv == T;
                        const unsigned long long meq = __ballot(eq);
                        const bool take = gt || (eq && (eqs + __builtin_popcountll(meq & lt)) < need);
                        const unsigned long long mt = __ballot(take);
                        if (take) sel[pos + __builtin_popcountll(mt & lt)] = (unsigned short)(lane + 64 * (4 * i8 + i));
                        pos += __builtin_popcountll(mt); eqs += __builtin_popcountll(meq);
                    } }
                }
                if (lane == 0) CNT[tt] = 256;
            }
      } else {
        asm volatile("s_waitcnt lgkmcnt(0)" ::: "memory");
        LAS unsigned char* KT = lds + DS_SC + w * 16384;
        const LAS float* RB = (const LAS float*)(lds + DS_RB);
        const int qq = l15 >> 2, pp = l15 & 3;
        const int tt = 2 * w + q2, t = t0 + tt, m = mb + t;
        const int cnt = CNT[tt], nt = (cnt + 31) >> 5;
        const LAS unsigned short* sel = SEL + tt * 256;
        bf16x8 qf[4];
#pragma unroll
        for (int ks = 0; ks < 4; ++ks) { qf[ks] = (bf16x8){0, 0, 0, 0, 0, 0, 0, 0}; if (l15 < 8) qf[ks] = *(const bf16x8*)(DQ + (size_t)m * 1024 + l15 * 128 + 32 * ks + 8 * g); }
        f32x4 oacc[8];
#pragma unroll
        for (int ct = 0; ct < 8; ++ct) oacc[ct] = (f32x4){0.f, 0.f, 0.f, 0.f};
        float mrun = -__builtin_inff(), lrun = 0.f;
        __builtin_amdgcn_s_waitcnt(0x0F70);
        unsigned lx[8];
#pragma unroll
        for (int j = 0; j < 8; ++j) lx[j] = (unsigned)((l15 ^ swzd(j + 8 * g)) << 4);
        const char* ckb = (const char*)CKV + ((size_t)mb << 8);
        const unsigned kt0a = (unsigned)__builtin_amdgcn_readfirstlane((int)LDS_ADDR(KT));
#define DS_GATHER_W(sw_) do { \
            glds16x8_asm(ckb, ((sw_.x & 0xffffu) << 8) + lx[0], ((sw_.x >> 16) << 8) + lx[1], ((sw_.y & 0xffffu) << 8) + lx[2], ((sw_.y >> 16) << 8) + lx[3], \
                              ((sw_.z & 0xffffu) << 8) + lx[4], ((sw_.z >> 16) << 8) + lx[5], ((sw_.w & 0xffffu) << 8) + lx[6], ((sw_.w >> 16) << 8) + lx[7], \
                         kt0a, kt0a + 1024u, kt0a + 2048u, kt0a + 3072u, kt0a + 4096u, kt0a + 5120u, kt0a + 6144u, kt0a + 7168u); } while (0)
#define DS_BIAS_ADDR(dst_, lt_) do { const int so_ = 32 * (lt_) + 4 * g; \
            const u32x2 s0_ = *(const LAS u32x2*)(sel + so_), s1_ = *(const LAS u32x2*)(sel + so_ + 16); \
            const int s8_[8] = {(int)(s0_.x & 0xffffu), (int)(s0_.x >> 16), (int)(s0_.y & 0xffffu), (int)(s0_.y >> 16), (int)(s1_.x & 0xffffu), (int)(s1_.x >> 16), (int)(s1_.y & 0xffffu), (int)(s1_.y >> 16)}; \
            _Pragma("unroll") for (int e = 0; e < 8; ++e) { int dist = t - s8_[e]; dist = dist > 128 ? 128 : dist; dst_[e] = dist * 32 + rbo; } } while (0)
        const int rbo = (l15 & 7) * 4;
        { const u32x4 swg0 = *(const LAS u32x4*)(sel + 8 * g); DS_GATHER_W(swg0); }
        float bnext[8];
        { int ba_[8]; DS_BIAS_ADDR(ba_, 0);
#pragma unroll
          for (int e = 0; e < 8; ++e) bnext[e] = *(const LAS float*)((const LAS unsigned char*)RB + ba_[e]); }
        const int ra_ = 4 * g + qq, rb_ = ra_ + 16;
        const int xa_ = swzd(ra_), xb_ = swzd(rb_), rhoa_ = 4 * (ra_ & 7) + (ra_ >> 3), rhob_ = 4 * (rb_ & 7) + (rb_ >> 3);
        const int xr_ = swzd(l15), rho_ = 4 * (l15 & 7) + (l15 >> 3);
        for (int lt = 0; lt < nt; ++lt) {
            float bcur[8];
#pragma unroll
            for (int e = 0; e < 8; ++e) bcur[e] = bnext[e];
            asm volatile("s_waitcnt vmcnt(0)" ::: "memory");
            __builtin_amdgcn_sched_barrier(0);
            bf16x8 vfr[8], kfr[2][4];
#pragma unroll
            for (int ct = 0; ct < 8; ++ct) { const int ch = 2 * ct + (pp >> 1);
                const v4i16_t va = __builtin_amdgcn_ds_read_tr16_b64_v4i16((LAS v4i16_t*)(KT + 256 * rhoa_ + 16 * (ch ^ xa_) + 8 * (pp & 1)));
                const v4i16_t vb = __builtin_amdgcn_ds_read_tr16_b64_v4i16((LAS v4i16_t*)(KT + 256 * rhob_ + 16 * (ch ^ xb_) + 8 * (pp & 1)));
                vfr[ct] = (bf16x8){va[0], va[1], va[2], va[3], vb[0], vb[1], vb[2], vb[3]}; }
#pragma unroll
            for (int kt = 0; kt < 2; ++kt)
#pragma unroll
                for (int ks = 0; ks < 4; ++ks) kfr[kt][ks] = *(const LAS bf16x8*)(KT + 512 * kt + 256 * rho_ + 16 * ((4 * ks + g) ^ xr_));
            const int ltn = lt + 1 < nt ? lt + 1 : lt;
            const u32x4 swg = *(const LAS u32x4*)(sel + 32 * ltn + 8 * g);
            int ba[8]; DS_BIAS_ADDR(ba, ltn);
            asm volatile("s_waitcnt lgkmcnt(0)" ::: "memory");
            __builtin_amdgcn_sched_barrier(0);
            if (lt + 1 < nt) DS_GATHER_W(swg);
#pragma unroll
            for (int e = 0; e < 8; ++e) bnext[e] = *(const LAS float*)((const LAS unsigned char*)RB + ba[e]);
            __builtin_amdgcn_sched_barrier(0);
            float lg[2][4];
#pragma unroll
            for (int kt = 0; kt < 2; ++kt) {
                f32x4 a0 = (f32x4){0.f, 0.f, 0.f, 0.f}, a1 = a0;
                a0 = __builtin_amdgcn_mfma_f32_16x16x32_bf16(kfr[kt][0], qf[0], a0, 0, 0, 0); a1 = __builtin_amdgcn_mfma_f32_16x16x32_bf16(kfr[kt][2], qf[2], a1, 0, 0, 0);
                a0 = __builtin_amdgcn_mfma_f32_16x16x32_bf16(kfr[kt][1], qf[1], a0, 0, 0, 0); a1 = __builtin_amdgcn_mfma_f32_16x16x32_bf16(kfr[kt][3], qf[3], a1, 0, 0, 0);
#pragma unroll
                for (int rr = 0; rr < 4; ++rr) lg[kt][rr] = (a0[rr] + a1[rr]) * (0.08838834764831845f * 1.4426950408889634f) + bcur[4 * kt + rr];
            }
            if (cnt - 32 * lt < 32) {
#pragma unroll
                for (int kt = 0; kt < 2; ++kt)
#pragma unroll
                    for (int rr = 0; rr < 4; ++rr) lg[kt][rr] = (32 * lt + 16 * kt + 4 * g + rr < cnt) ? lg[kt][rr] : -__builtin_inff();
            }
            float tmax;
            { float m1_, m2_; asm("v_max3_f32 %0, %1, %2, %3" : "=v"(m1_) : "v"(lg[0][0]), "v"(lg[0][1]), "v"(lg[0][2]));
              asm("v_max3_f32 %0, %1, %2, %3" : "=v"(m2_) : "v"(lg[0][3]), "v"(lg[1][0]), "v"(lg[1][1]));
              asm("v_max3_f32 %0, %1, %2, %3" : "=v"(m1_) : "v"(m1_), "v"(lg[1][2]), "v"(lg[1][3]));
              asm("v_max_f32 %0, %1, %2" : "=v"(tmax) : "v"(m1_), "v"(m2_)); }
            tmax = rows4_max_fast(tmax);
            if (__any(tmax > mrun + 8.0f)) {
                const float mnew = fmaxf(mrun, tmax), alpha = __builtin_amdgcn_exp2f(mrun - mnew);
                lrun *= alpha; mrun = mnew;
#pragma unroll
                for (int ct = 0; ct < 8; ++ct) oacc[ct] = oacc[ct] * alpha;
            }
            float psum = 0.f;
#pragma unroll
            for (int kt = 0; kt < 2; ++kt)
#pragma unroll
                for (int rr = 0; rr < 4; ++rr) { lg[kt][rr] = __builtin_amdgcn_exp2f(lg[kt][rr] - mrun); psum += lg[kt][rr]; }
            lrun += psum;
            {
                u32x4 pw; pw.x = pg8::cvt_pk_bf16(lg[0][0], lg[0][1]); pw.y = pg8::cvt_pk_bf16(lg[0][2], lg[0][3]);
                pw.z = pg8::cvt_pk_bf16(lg[1][0], lg[1][1]); pw.w = pg8::cvt_pk_bf16(lg[1][2], lg[1][3]);
                const bf16x8 pf = __builtin_bit_cast(bf16x8, pw);
#pragma unroll
                for (int ct = 0; ct < 8; ++ct) oacc[ct] = __builtin_amdgcn_mfma_f32_16x16x32_bf16(vfr[ct], pf, oacc[ct], 0, 0, 0);
            }
            asm volatile("s_waitcnt lgkmcnt(0)" ::: "memory");
            __builtin_amdgcn_sched_barrier(0);
        }
#undef DS_GATHER_W
#undef DS_BIAS_ADDR
        lrun = rows4_sum(lrun);
        const float inv = __builtin_amdgcn_rcpf(lrun);
        if (l15 < 8) {
#pragma unroll
            for (int ct = 0; ct < 8; ++ct) { u32x2 ow; ow.x = pg8::cvt_pk_bf16(oacc[ct][0] * inv, oacc[ct][1] * inv); ow.y = pg8::cvt_pk_bf16(oacc[ct][2] * inv, oacc[ct][3] * inv);
                *(u32x2*)(DQ + (size_t)m * 1024 + l15 * 128 + 16 * ct + 4 * g) = ow; }
        }
        asm volatile("s_waitcnt vmcnt(0)" ::: "memory");
      }
    }
    __syncthreads();
}

#define XB_TMO      128
#define XB_XCNT(j)  (256  + 64 * (j))
#define XB_XSUB(j)  (1280 + 64 * (j))
#define XB_XGEN(j)  (2304 + 64 * (j))
#define XB_TOP      3328
#define XB_TOPGEN   3392
#define XCD_BAR_WORDS 3456
#define XB_SPIN_CAP (1u << 20)
__device__ __forceinline__ unsigned xb_ld(unsigned* p)              { return __hip_atomic_load(p, __ATOMIC_RELAXED, __HIP_MEMORY_SCOPE_AGENT); }
__device__ __forceinline__ unsigned xb_add(unsigned* p, unsigned v) { return __hip_atomic_fetch_add(p, v, __ATOMIC_RELAXED, __HIP_MEMORY_SCOPE_AGENT); }
__device__ __forceinline__ unsigned xb_xcc_id() { return (unsigned)__builtin_amdgcn_s_getreg((3 << 11) | 20) & 0xFu; }
#define XB_SPIN(cond, bar) do { unsigned _sp = 0; while (cond) { __builtin_amdgcn_s_sleep(1); \
    if ((++_sp & 255u) == 0u) { if (xb_ld(&(bar)[XB_TMO])) break; if (_sp > XB_SPIN_CAP) { atomicAdd(&(bar)[XB_TMO], 1u); break; } } } } while (0)
__device__ __forceinline__ void xcd_barrier_complete(unsigned* bar, unsigned x, unsigned G, unsigned& nloc, unsigned& nx) {
    unsigned sum, cnt, mine, sp = 0u;
    for (;;) {
        sum = 0u; cnt = 0u; mine = 0u;
#pragma unroll
        for (unsigned j = 0; j < 16; ++j) { const unsigned c = xb_ld(&bar[XB_XCNT(j)]); sum += c; cnt += (c > 0u) ? 1u : 0u; mine = (j == x) ? c : mine; }
        if (sum == G) break;
        __builtin_amdgcn_s_sleep(1);
        if ((++sp & 255u) == 0u) { if (xb_ld(&bar[XB_TMO])) break; if (sp > XB_SPIN_CAP) { atomicAdd(&bar[XB_TMO], 1u); break; } }
    }
    nloc = mine > 0u ? mine : 1u; nx = cnt > 0u ? cnt : 1u;
}
__device__ __forceinline__ void xcd_barrier(unsigned* bar, volatile LAS unsigned* st, bool leader, unsigned G) {
    asm volatile("s_waitcnt vmcnt(0)" ::: "memory");
    __syncthreads();
    if (leader) {
        __builtin_amdgcn_s_waitcnt(0);
        const unsigned x = xb_xcc_id();
        unsigned nloc = st[0], nx = st[1];
        if (nloc == 0u) { xcd_barrier_complete(bar, x, G, nloc, nx); st[0] = nloc; st[1] = nx; }
        const unsigned old = xb_add(&bar[XB_XSUB(x)], 1u);
        const unsigned gen = old / nloc;
        if (old + 1u == (gen + 1u) * nloc) {
            __builtin_amdgcn_fence(__ATOMIC_RELEASE, "agent");
            asm volatile("s_waitcnt vmcnt(0)" ::: "memory");
            const unsigned og = xb_add(&bar[XB_TOP], 1u);
            const unsigned tg = og / nx;
            if (og + 1u == (tg + 1u) * nx) xb_add(&bar[XB_TOPGEN], 1u);
            else XB_SPIN(xb_ld(&bar[XB_TOPGEN]) == tg, bar);
            __builtin_amdgcn_fence(__ATOMIC_ACQUIRE, "agent");
            xb_add(&bar[XB_XGEN(x)], 1u);
            asm volatile("s_waitcnt vmcnt(0)" ::: "memory");
        } else {
            XB_SPIN(xb_ld(&bar[XB_XGEN(x)]) == gen, bar);
            __builtin_amdgcn_fence(__ATOMIC_ACQUIRE, "agent");
            asm volatile("s_waitcnt vmcnt(0)" ::: "memory");
        }
    }
    __syncthreads();
}

struct Args { const float* in[22]; float* out; unsigned char* ws; int ph_lo, ph_hi; };

__global__ void __launch_bounds__(512, 2) fwd_kernel(Args args) {
    extern __shared__ __attribute__((aligned(16))) unsigned char lds_raw[];
    LAS unsigned char* lds = (LAS unsigned char*)lds_raw;
    const int wave = __builtin_amdgcn_readfirstlane(threadIdx.x >> 6);
    const int G = gridDim.x, bid = blockIdx.x;
    unsigned char* ws = args.ws;
    unsigned* ctl = (unsigned*)(ws + WS_CTL);
    const float* x = args.in[0]; const float* p = args.in[1];
    float* out = args.out;
    const int lo = args.ph_lo, hi = args.ph_hi;
#define IN(k) (lo <= (k) && (k) < hi)
#if MK_N_LAUNCHES == 1
    unsigned* const gbar = ctl + CW_BAR;
    volatile LAS unsigned* const bst = (volatile LAS unsigned*)(lds + LDS_MISC + 32);
    { const bool ldr = (wave == 0 && lane_id() == 0);
      if (ldr) { bst[0] = 0u; bst[1] = 0u; (void)xb_add(&gbar[XB_XCNT(xb_xcc_id())], 1u); }
      __syncthreads(); }
#define SEAM(k) do { if (IN(k) && IN((k) + 1)) { xcd_barrier(gbar, bst, (wave == 0 && lane_id() == 0), (unsigned)G); } } while (0)
#else
#define SEAM(k) do { } while (0)
#endif
    bf16_t* HI = (bf16_t*)(ws + WS_HI);
    bf16_t* HID = (bf16_t*)(ws + WS_HID);
    const int gw = bid * 8 + wave, NGW = G * 8;

    if (IN(0)) {
        const int lane = lane_id();
        LAS float* scr = (LAS float*)(lds + wave * 16384);
#define TJOB(W_, K_, N_, WT_, GAIN_, MODE_) do { const int ni_ = ((K_) / 64) * (((N_) + 31) / 32); \
            for (int it_ = gw; it_ < ni_; it_ += NGW) transpose_item((W_), (K_), (N_), (bf16_t*)(ws + (WT_)), (GAIN_), (MODE_), scr, it_, lane); } while (0)
        TJOB(args.in[3], DM, FF2, WS_BT1, args.in[2], 1);
        for (int m2 = gw; m2 < MROWS / 2; m2 += NGW) {
            f32x4 v[2][4]; float sq[2];
#pragma unroll
            for (int r = 0; r < 2; ++r) { const f32x4* xr = (const f32x4*)(x + (size_t)(2 * m2 + r) * DM) + lane;
#pragma unroll
                for (int j = 0; j < 4; ++j) v[r][j] = xr[64 * j]; }
#pragma unroll
            for (int r = 0; r < 2; ++r) { float s = 0.f;
#pragma unroll
                for (int j = 0; j < 4; ++j) s += (v[r][j][0] * v[r][j][0] + v[r][j][1] * v[r][j][1]) + (v[r][j][2] * v[r][j][2] + v[r][j][3] * v[r][j][3]);
                sq[r] = s; }
#pragma unroll
            for (int r = 0; r < 2; ++r) { const float ms = wave_sum(sq[r]) * (1.0f / DM) + EPS; const float rs = __builtin_amdgcn_rsqf(ms);
                if (lane == 0) ((float*)(ws + WS_RSX))[2 * m2 + r] = __builtin_amdgcn_sqrtf(ms);
                u32x2* o8 = (u32x2*)(HI + (size_t)(2 * m2 + r) * DM) + lane;
#pragma unroll
                for (int j = 0; j < 4; ++j) { u32x2 o; o.x = pg8::cvt_pk_bf16(v[r][j][0] * rs, v[r][j][1] * rs); o.y = pg8::cvt_pk_bf16(v[r][j][2] * rs, v[r][j][3] * rs); o8[64 * j] = o; } }
        }
        __syncthreads();
    }
    SEAM(0);
    if (IN(1)) {
        pg8::Gemm g{HI, (const bf16_t*)(ws + WS_BT1), MROWS, FF2, DM}; pg8::StaticOrder S; S.init(MROWS, FF2, G, bid);
        pg8::EpiSwiglu E{HID, nullptr};
        pg8::gemm_phase<pg8::EpiSwiglu, pg8::StaticOrder, true, true, 8>(lds, g, S, E, wave);
        {
            LAS int* bc = (LAS int*)(lds + LDS_MISC); LAS float* scr = (LAS float*)(lds + wave * 16384); const int lane = lane_id();
            constexpr int I2 = (FF / 64) * (DM / 32), I3 = (DM / 64) * ((6872 + 31) / 32), ITOT = I2 + I3;
            for (;;) {
                __syncthreads();
                if (wave == 0 && lane == 0) bc[0] = (int)atomicAdd(&ctl[CW_TQ], 1u);
                __syncthreads();
                const int it = bc[0] * 8 + wave;
                if (bc[0] * 8 >= ITOT) break;
                if (it < I2) transpose_item(args.in[4], FF, DM, (bf16_t*)(ws + WS_BT2), nullptr, 0, scr, it, lane);
                else if (it < ITOT) transpose_item(args.in[6], DM, 6872, (bf16_t*)(ws + WS_BT3), args.in[5], 2, scr, it - I2, lane);
            }
            __syncthreads();
        }
    }
    SEAM(1);
    if (IN(2)) {
        pg8::Gemm g{HID, (const bf16_t*)(ws + WS_BT2), MROWS, DM, FF}; pg8::StaticOrder S; S.init(MROWS, DM, G, bid);
        pg8::EpiResidH E{HI, (float*)(ws + WS_RSS1), 0.5f, lds, (const float*)(ws + WS_RSX)};
        pg8::gemm_phase<pg8::EpiResidH, pg8::StaticOrder>(lds, g, S, E, wave);
    }
    SEAM(2);
    if (IN(3)) {
        pg8::Gemm g{HI, (const bf16_t*)(ws + WS_BT3), MROWS, NIN, DM}; pg8::StaticOrder S; S.init(MROWS, NIN, G, bid, 8);
        pg8::EpiInproj E{ws, (bf16_t*)out, (const float*)(ws + WS_RSS1), args.in[11], lds};
        pg8::gemm_phase<pg8::EpiInproj, pg8::StaticOrder, true, true, 8>(lds, g, S, E, wave);
        {
            LAS int* bc = (LAS int*)(lds + LDS_MISC); LAS float* scr = (LAS float*)(lds + wave * 16384); const int lane = lane_id();
            constexpr int I1 = (DM / 64) * (DM / 32), ITOT = 3 * I1;
            for (;;) {
                __syncthreads();
                if (wave == 0 && lane == 0) bc[0] = (int)atomicAdd(&ctl[CW_TQ + 3], 1u);
                __syncthreads();
                const int it = bc[0] * 8 + wave;
                if (bc[0] * 8 >= ITOT) break;
                if (it < I1) transpose_item(args.in[10], DM, DM, (bf16_t*)(ws + WS_BTA), nullptr, 0, scr, it, lane);
                else if (it < 2 * I1) transpose_item(args.in[12], DM, DM, (bf16_t*)(ws + WS_BTB), nullptr, 0, scr, it - I1, lane);
                else if (it < ITOT) transpose_item(args.in[14], DM, DM, (bf16_t*)(ws + WS_BTO), nullptr, 0, scr, it - 2 * I1, lane);
            }
            __syncthreads();
        }
    }
    SEAM(3);
    if (IN(4)) {
        LAS int* bc = (LAS int*)(lds + LDS_MISC);
        float* DECG = (float*)(ws + WS_DECG); float* STATE = (float*)(ws + WS_GLAST);
        { LAS float* RBw = (LAS float*)(lds + DS_RB); const int l_ = lane_id();
          for (int e = wave * 64 + l_; e < 129 * 8; e += 512) RBw[e] = args.in[13][t5_bucket(e >> 3) * 8 + (e & 7)] * 1.4426950408889634f; }
        int qx = (int)(xb_xcc_id() & 7u), qdone = 0;
        for (;;) {
            __syncthreads();
            if (wave == 0 && lane_id() == 0) bc[0] = (int)atomicAdd(&ctl[CW_QUEUE + 64 * qx], 1u);
            __syncthreads();
            const int item = bc[0];
            if (item >= 64 + 20 + 128) { if (++qdone == 8) break; qx = (qx + 1) & 7; continue; }
            if (item < 64) gla_prep_item(qx, item & 3, item >> 2, ws, args.in[7], args.in[8], DECG, ctl + CW_GLACNT, lds, wave);
            else if (item < 72) { const int k = item - 64, sg = k >> 2;
                gla_item<false>(qx, k & 3, 11 * sg, 11 * sg + 11, 0, sg, ws, args.in[9], DECG, STATE, ctl + CW_GLACNT, ctl + CW_GLAST, ctl + CW_TMO, lds, wave); }
            else if (item < 96) dsa_item(qx, 127 - (item - 72), ws, args.in[13], lds, wave);
            else if (item < 108) { const int k = item - 96, sg = k >> 2;
                gla_item<true>(qx, k & 3, 11 * sg, sg == 2 ? 32 : 11 * sg + 11, sg, 0, ws, args.in[9], DECG, STATE, ctl + CW_GLACNT, ctl + CW_GLAST, ctl + CW_TMO, lds, wave); }
            else dsa_item(qx, 127 - (item - 84), ws, args.in[13], lds, wave);
        }
        {
            LAS float* scr = (LAS float*)(lds + wave * 16384); const int lane = lane_id();
            constexpr int ITOT = (DM / 64) * (FF2 / 32);
            for (;;) {
                __syncthreads();
                if (wave == 0 && lane == 0) bc[0] = (int)atomicAdd(&ctl[CW_TQ + 2], 1u);
                __syncthreads();
                const int it = bc[0] * 8 + wave;
                if (bc[0] * 8 >= ITOT) break;
                if (it < ITOT) transpose_item(args.in[16], DM, FF2, (bf16_t*)(ws + WS_BT8), args.in[15], 1, scr, it, lane);
            }
            __syncthreads();
        }
    }
    SEAM(4);
    if (IN(5)) {
        bf16_t* MG = (bf16_t*)(ws + WS_GR);
        { pg8::Gemm g{(const bf16_t*)(ws + WS_GV), (const bf16_t*)(ws + WS_BTA), MROWS, DM, DM}; pg8::StaticOrder S; S.init(MROWS, DM, G, bid);
          pg8::EpiMerge E{MG, (const bf16_t*)out, 0, lds};
          pg8::gemm_phase<pg8::EpiMerge, pg8::StaticOrder>(lds, g, S, E, wave); }
        { pg8::Gemm g{(const bf16_t*)(ws + WS_DQ), (const bf16_t*)(ws + WS_BTB), MROWS, DM, DM}; pg8::StaticOrder S; S.init(MROWS, DM, G, bid);
          pg8::EpiMerge E{MG, (const bf16_t*)out, 1, lds};
          pg8::gemm_phase<pg8::EpiMerge, pg8::StaticOrder>(lds, g, S, E, wave); }
    }
    SEAM(5);
    if (IN(6)) {
        pg8::Gemm g{(const bf16_t*)(ws + WS_GR), (const bf16_t*)(ws + WS_BTO), MROWS, DM, DM}; pg8::StaticOrder S; S.init(MROWS, DM, G, bid);
        pg8::EpiResidH E{HI, (float*)(ws + WS_RSS2), 1.0f, lds, nullptr};
        pg8::gemm_phase<pg8::EpiResidH, pg8::StaticOrder>(lds, g, S, E, wave);
    }
    SEAM(6);
    if (IN(7)) {
        pg8::Gemm g{HI, (const bf16_t*)(ws + WS_BT8), MROWS, FF2, DM}; pg8::StaticOrder S; S.init(MROWS, FF2, G, bid);
        pg8::EpiSwiglu E{HID, (const float*)(ws + WS_RSS2)};
        pg8::gemm_phase<pg8::EpiSwiglu, pg8::StaticOrder, true, true, 8>(lds, g, S, E, wave);
        {
            LAS int* bc = (LAS int*)(lds + LDS_MISC); LAS float* scr = (LAS float*)(lds + wave * 16384); const int lane = lane_id();
            constexpr int I9 = (FF / 64) * (DM / 32), IG = (DM / 64) * (DM / 32), IP = (PLE / 64) * (DM / 32), IPB = MROWS * PLE / 2048, ITOT = I9 + IG + IP + IPB;
            bf16_t* PB = (bf16_t*)(ws + WS_PB);
            for (;;) {
                __syncthreads();
                if (wave == 0 && lane == 0) bc[0] = (int)atomicAdd(&ctl[CW_TQ + 1], 1u);
                __syncthreads();
                const int it = bc[0] * 8 + wave;
                if (bc[0] * 8 >= ITOT) break;
                if (it < I9) transpose_item(args.in[17], FF, DM, (bf16_t*)(ws + WS_BT9), nullptr, 0, scr, it, lane);
                else if (it < I9 + IG) transpose_item(args.in[19], DM, DM, (bf16_t*)(ws + WS_BTG), args.in[18], 0, scr, it - I9, lane);
                else if (it < I9 + IG + IP) transpose_item(args.in[20], PLE, DM, (bf16_t*)(ws + WS_BTP), nullptr, 0, scr, it - I9 - IG, lane);
                else if (it < ITOT) { const size_t base = (size_t)(it - I9 - IG - IP) * 2048 + lane * 4; f32x4 v[8];
#pragma unroll
                    for (int u = 0; u < 8; ++u) v[u] = *(const f32x4*)(p + base + u * 256);
#pragma unroll
                    for (int u = 0; u < 8; ++u) { u32x2 o; o.x = pg8::cvt_pk_bf16(v[u][0], v[u][1]); o.y = pg8::cvt_pk_bf16(v[u][2], v[u][3]); *(u32x2*)(PB + base + u * 256) = o; } }
            }
            __syncthreads();
        }
    }
    SEAM(7);
    if (IN(8)) {
        pg8::Gemm g{HID, (const bf16_t*)(ws + WS_BT9), MROWS, DM, FF}; pg8::StaticOrder S; S.init(MROWS, DM, G, bid);
        pg8::EpiResidH E{HI, (float*)(ws + WS_RSS3), 0.5f, lds, nullptr};
        pg8::gemm_phase<pg8::EpiResidH, pg8::StaticOrder>(lds, g, S, E, wave);
    }
    SEAM(8);
    if (IN(9)) {
        { pg8::Gemm g{(const bf16_t*)(ws + WS_PB), (const bf16_t*)(ws + WS_BTP), MROWS, DM, PLE}; pg8::StaticOrder S; S.init(MROWS, DM, G, bid);
          pg8::EpiPle E{(bf16_t*)(ws + WS_BIG)};
          pg8::gemm_phase<pg8::EpiPle, pg8::StaticOrder>(lds, g, S, E, wave); }
        { pg8::Gemm g{HI, (const bf16_t*)(ws + WS_BTG), MROWS, DM, DM}; pg8::StaticOrder S; S.init(MROWS, DM, G, bid);
          pg8::EpiPleFinal E{out, HI, (const bf16_t*)(ws + WS_BIG), (const float*)(ws + WS_RSS3), args.in[21], (unsigned*)(ws + WS_RSS4), ctl + CW_PLEC, ctl + CW_TMO, lds};
          pg8::gemm_phase<pg8::EpiPleFinal, pg8::StaticOrder>(lds, g, S, E, wave); }
    }
#undef IN
#undef SEAM
}

extern "C" void kernel_launch(void* const* d_in, const int* in_sizes, int n_in, void* d_out, int out_size, void* d_ws, size_t ws_size, hipStream_t stream) {
    static int grid = 0;
    if (grid == 0) {
        if (n_in != 22 || out_size != MROWS * DM || ws_size < WS_END) { fprintf(stderr, "kernel_launch: unexpected problem shape (n_in %d out %d ws %zu)\n", n_in, out_size, ws_size); grid = -1; return; }
        int dev = 0, cus = 0, per_cu = 0;
        (void)hipGetDevice(&dev); (void)hipDeviceGetAttribute(&cus, hipDeviceAttributeMultiprocessorCount, dev);
        if (hipFuncSetAttribute((const void*)fwd_kernel, hipFuncAttributeMaxDynamicSharedMemorySize, LDS_BYTES) != hipSuccess) { fprintf(stderr, "kernel_launch: hipFuncSetAttribute failed\n"); grid = -1; return; }
        if (hipOccupancyMaxActiveBlocksPerMultiprocessor(&per_cu, (const void*)fwd_kernel, 512, LDS_BYTES) != hipSuccess || per_cu < 1) { fprintf(stderr, "kernel_launch: occupancy query says %d\n", per_cu); per_cu = 1; }
        (void)hipGetLastError();
        grid = cus * 1;
        if (grid > 256) grid = 256;
    }
    if (grid < 0) return;
    (void)hipMemsetAsync((char*)d_ws + WS_CTL, 0, CTL_BYTES, stream);
    Args a{};
    for (int i = 0; i < 22; ++i) a.in[i] = (const float*)d_in[i];
    a.out = (float*)d_out; a.ws = (unsigned char*)d_ws;
    if (MK_N_LAUNCHES == 1) {
        a.ph_lo = 0; a.ph_hi = NPHASE;
        void* kargs[] = {&a};
        hipError_t e = hipLaunchCooperativeKernel((const void*)fwd_kernel, dim3(grid), dim3(512), kargs, LDS_BYTES, stream);
        if (e != hipSuccess) fprintf(stderr, "cooperative launch failed: %s (grid %d)\n", hipGetErrorString(e), grid);
    } else {
        for (int ph = 0; ph < NPHASE; ++ph) {
            a.ph_lo = ph; a.ph_hi = ph + 1;
            hipLaunchKernelGGL(fwd_kernel, dim3(grid), dim3(512), LDS_BYTES, stream, a);
        }
    }
}
```

```cpp
#include <hip/hip_runtime.h>
#include <hip/hip_cooperative_groups.h>
#include <cstdio>
#include <cstdint>
namespace cg = cooperative_groups;

#ifndef MK_N_LAUNCHES
#define MK_N_LAUNCHES 1
#endif

#define LAS __attribute__((address_space(3)))
#define GAS __attribute__((address_space(1)))
typedef unsigned short bf16_t;
typedef short bf16x8 __attribute__((ext_vector_type(8)));
typedef float f32x4 __attribute__((ext_vector_type(4)));
typedef float f32x2 __attribute__((ext_vector_type(2)));
typedef unsigned u32x4 __attribute__((ext_vector_type(4)));
typedef unsigned u32x2 __attribute__((ext_vector_type(2)));

constexpr int NB = 8, SEQ = 2048, DM = 1024, MROWS = NB * SEQ;
constexpr int FF = 2816, FF2 = 2 * FF;
constexpr int PLE = 256;
constexpr int NIN = 6912;
constexpr float EPS = 1e-6f;
constexpr int NPHASE = 10;

constexpr size_t MiB = 1u << 20;
constexpr size_t WS_CTL = 0, CTL_BYTES = 65536;
constexpr size_t WS_RSX = 4 * MiB + 512 * 1024;
constexpr size_t WS_RSS1 = 1 * MiB, WS_RSS2 = 2 * MiB, WS_RSS3 = 3 * MiB, WS_RSS4 = 4 * MiB;
constexpr size_t WS_BT3 = 5 * MiB;
constexpr size_t WS_BTA = WS_BT3 + 27 * MiB / 2;
constexpr size_t WS_BTB = WS_BTA + 2 * MiB, WS_BTO = WS_BTB + 2 * MiB;
constexpr size_t WS_WB = WS_BTO + 2 * MiB;
constexpr size_t WS_BT1 = WS_WB, WS_BT2 = WS_WB + 11 * MiB;
constexpr size_t WS_CKV = WS_WB, WS_IK = WS_WB + 4 * MiB, WS_IW = WS_WB + 6 * MiB, WS_GA = WS_WB + 6 * MiB + MiB / 2;
constexpr size_t WS_DECG = WS_WB + 8 * MiB;
constexpr size_t WS_GLAST = WS_WB + 8 * MiB + MiB / 2;
constexpr size_t WS_BTG = WS_WB + 8 * MiB, WS_BT9 = WS_WB + 10 * MiB + MiB / 2;
constexpr size_t WS_HI = 41 * MiB, WS_LO = 73 * MiB;
constexpr size_t WS_PB = WS_LO, WS_BTP = WS_LO + 8 * MiB;
constexpr size_t WS_BIG = 105 * MiB;
constexpr size_t WS_GQ = WS_BIG, WS_GK = WS_BIG + 16 * MiB, WS_IQ = WS_BIG + 32 * MiB, WS_DQ = WS_BIG + 48 * MiB, WS_GV = WS_BIG + 80 * MiB, WS_GR = WS_BIG + 112 * MiB;
constexpr size_t WS_HID = WS_BIG;
constexpr size_t WS_PROJ = WS_BIG + 88 * MiB;
constexpr size_t WS_BT8 = WS_BT3;
constexpr size_t WS_END = WS_BIG + 144 * MiB;
static_assert(WS_BT9 + 11 * MiB / 2 <= WS_HI && WS_GA + MiB <= WS_BT2 && WS_END <= 256 * MiB, "ws map");

constexpr int CW_TMO = 32;
constexpr int CW_GLACNT = 128;
constexpr int CW_GLAST = 8192;
constexpr int CW_QUEUE = 7680;
constexpr int CW_PLEC = 12288;
constexpr int CW_TQ = 48;
constexpr int CW_BAR = 4096;

constexpr int LDS_BYTES = 151552;
constexpr int LDS_EPI = 131072;
constexpr int LDS_MISC = 151552 - 256;

__device__ __forceinline__ unsigned f2bf(float f) { unsigned u = __builtin_bit_cast(unsigned, f); return (u + 0x7fffu + ((u >> 16) & 1u)) >> 16; }
__device__ __forceinline__ float bf2f(unsigned h) { return __builtin_bit_cast(float, h << 16); }
__device__ __forceinline__ unsigned pk2(float lo, float hi) { return f2bf(lo) | (f2bf(hi) << 16); }
__device__ __forceinline__ float bflo(unsigned w) { return __builtin_bit_cast(float, w << 16); }
__device__ __forceinline__ float bfhi(unsigned w) { return __builtin_bit_cast(float, w & 0xffff0000u); }
__device__ __forceinline__ float sigmoidf_(float x) { return __builtin_amdgcn_rcpf(1.0f + __expf(-x)); }
__device__ __forceinline__ float siluf_(float x) { return x * __builtin_amdgcn_rcpf(1.0f + __expf(-x)); }
__device__ __forceinline__ int lane_id() { int l; asm volatile("v_mbcnt_lo_u32_b32 %0, -1, 0\n\tv_mbcnt_hi_u32_b32 %0, -1, %0" : "=v"(l)); return l; }
__device__ __forceinline__ void glds16_asm(const void* gsrc, unsigned lds_dst) { unsigned keep;
    asm volatile("s_mov_b32 %0, m0\n\ts_mov_b32 m0, %2\n\ts_nop 0\n\tglobal_load_lds_dwordx4 %1, off\n\ts_mov_b32 m0, %0" : "=&s"(keep) : "v"(gsrc), "s"(lds_dst) : "memory"); }
__device__ __forceinline__ void glds4_asm(const void* gsrc, unsigned lds_dst) { unsigned keep;
    asm volatile("s_mov_b32 %0, m0\n\ts_mov_b32 m0, %2\n\ts_nop 0\n\tglobal_load_lds_dword %1, off\n\ts_mov_b32 m0, %0" : "=&s"(keep) : "v"(gsrc), "s"(lds_dst) : "memory"); }
#define LDS_ADDR(p) ((unsigned)(size_t)(p))
__device__ __forceinline__ void swap16(float& x, float& y) { asm volatile("s_nop 1\n\tv_permlane16_swap_b32 %0, %1" : "+v"(x), "+v"(y)); }
__device__ __forceinline__ void swap32(float& x, float& y) { asm volatile("s_nop 1\n\tv_permlane32_swap_b32 %0, %1" : "+v"(x), "+v"(y)); }
__device__ __forceinline__ float rows4_sum(float v) { float x = v, y = v; swap16(x, y); v = x + y; x = v; y = v; swap32(x, y); return x + y; }
__device__ __forceinline__ float rows4_max(float v) { float x = v, y = v; swap16(x, y); v = fmaxf(x, y); x = v; y = v; swap32(x, y); return fmaxf(x, y); }
__device__ __forceinline__ float rows4_max_fast(float v) { float x = v, y;
    asm volatile("v_mov_b32 %1, %0\n\ts_nop 1\n\tv_permlane16_swap_b32 %0, %1\n\ts_nop 0\n\tv_max_f32 %0, %0, %1\n\tv_mov_b32 %1, %0\n\ts_nop 1\n\tv_permlane32_swap_b32 %0, %1\n\ts_nop 0\n\tv_max_f32 %0, %0, %1" : "+v"(x), "=&v"(y));
    return x; }
__device__ __forceinline__ void glds16x8_asm(const void* sbase, unsigned o0, unsigned o1, unsigned o2, unsigned o3, unsigned o4, unsigned o5, unsigned o6, unsigned o7,
                                             unsigned l0, unsigned l1, unsigned l2, unsigned l3, unsigned l4, unsigned l5, unsigned l6, unsigned l7) { unsigned keep;
    asm volatile("s_mov_b32 %0, m0\n\t"
                 "s_mov_b32 m0, %10\n\ts_nop 0\n\tglobal_load_lds_dwordx4 %2, %1\n\t"
                 "s_mov_b32 m0, %11\n\ts_nop 0\n\tglobal_load_lds_dwordx4 %3, %1\n\t"
                 "s_mov_b32 m0, %12\n\ts_nop 0\n\tglobal_load_lds_dwordx4 %4, %1\n\t"
                 "s_mov_b32 m0, %13\n\ts_nop 0\n\tglobal_load_lds_dwordx4 %5, %1\n\t"
                 "s_mov_b32 m0, %14\n\ts_nop 0\n\tglobal_load_lds_dwordx4 %6, %1\n\t"
                 "s_mov_b32 m0, %15\n\ts_nop 0\n\tglobal_load_lds_dwordx4 %7, %1\n\t"
                 "s_mov_b32 m0, %16\n\ts_nop 0\n\tglobal_load_lds_dwordx4 %8, %1\n\t"
                 "s_mov_b32 m0, %17\n\ts_nop 0\n\tglobal_load_lds_dwordx4 %9, %1\n\t"
                 "s_mov_b32 m0, %0"
                 : "=&s"(keep) : "s"(sbase), "v"(o0), "v"(o1), "v"(o2), "v"(o3), "v"(o4), "v"(o5), "v"(o6), "v"(o7),
                   "s"(l0), "s"(l1), "s"(l2), "s"(l3), "s"(l4), "s"(l5), "s"(l6), "s"(l7) : "memory"); }
__device__ __forceinline__ int wave_imax(int v) {
    v = max(v, __builtin_amdgcn_update_dpp(0, v, 0xB1, 0xf, 0xf, false)); v = max(v, __builtin_amdgcn_update_dpp(0, v, 0x4E, 0xf, 0xf, false));
    v = max(v, __builtin_amdgcn_update_dpp(0, v, 0x141, 0xf, 0xf, false)); v = max(v, __builtin_amdgcn_update_dpp(0, v, 0x140, 0xf, 0xf, false));
    return max(max(__builtin_amdgcn_readlane(v, 0), __builtin_amdgcn_readlane(v, 16)), max(__builtin_amdgcn_readlane(v, 32), __builtin_amdgcn_readlane(v, 48)));
}
__device__ __forceinline__ unsigned wave_umax(unsigned u) {
    int v = (int)u;
    v = (int)max((unsigned)v, (unsigned)__builtin_amdgcn_update_dpp(0, v, 0xB1, 0xf, 0xf, false)); v = (int)max((unsigned)v, (unsigned)__builtin_amdgcn_update_dpp(0, v, 0x4E, 0xf, 0xf, false));
    v = (int)max((unsigned)v, (unsigned)__builtin_amdgcn_update_dpp(0, v, 0x141, 0xf, 0xf, false)); v = (int)max((unsigned)v, (unsigned)__builtin_amdgcn_update_dpp(0, v, 0x140, 0xf, 0xf, false));
    return max(max((unsigned)__builtin_amdgcn_readlane(v, 0), (unsigned)__builtin_amdgcn_readlane(v, 16)), max((unsigned)__builtin_amdgcn_readlane(v, 32), (unsigned)__builtin_amdgcn_readlane(v, 48)));
}
__device__ __forceinline__ int wave_isum(int v) {
    v += __builtin_amdgcn_update_dpp(0, v, 0xB1, 0xf, 0xf, false);
    v += __builtin_amdgcn_update_dpp(0, v, 0x4E, 0xf, 0xf, false);
    v += __builtin_amdgcn_update_dpp(0, v, 0x141, 0xf, 0xf, false);
    v += __builtin_amdgcn_update_dpp(0, v, 0x140, 0xf, 0xf, false);
    return __builtin_amdgcn_readlane(v, 0) + __builtin_amdgcn_readlane(v, 16) + __builtin_amdgcn_readlane(v, 32) + __builtin_amdgcn_readlane(v, 48);
}
__device__ __forceinline__ float wave_sum(float v) {
#pragma unroll
    for (int o = 1; o < 64; o <<= 1) v += __shfl_xor(v, o);
    return v;
}

namespace pg8 {
constexpr int BM = 256, BK = 64, HALF = 128, HTB = HALF * BK * 2, STAGE_BYTES = 8 * HTB, NXCD = 8, WGM = 4;
__host__ __device__ __forceinline__ int lds_byte(int r, int c) { const int st = (r >> 4) * 2 + (c >> 5), rr = r & 15, cc = c & 31, ob = rr * 64 + cc * 2; return st * 1024 + (ob ^ (((ob >> 9) & 1) << 5)); }
__host__ __device__ __forceinline__ void stage_rc(int b, int& R, int& C) { const int st = b / 1024, sb = b % 1024, swz = sb ^ (((sb >> 9) & 1) << 5); R = (st >> 1) * 16 + swz / 64; C = (st & 1) * 32 + (swz % 64) / 2; }
__host__ __device__ __forceinline__ int perm32(int rho) { const int n = rho >> 4, i = rho & 15; return 8 * (i >> 2) + 4 * n + (i & 3); }

struct Unit { int pm, pn; };
struct Gemm { const bf16_t* A; const bf16_t* Bt; int M, N, K; };

struct StaticOrder {
    int nM, nN, nwg, G, c;
    __host__ __device__ void init(int M, int N, int G_, int c_) { nM = M / BM; nN = N / BM; nwg = nM * nN; G = G_; c = c_; }
    __host__ __device__ bool next(int i, Unit& u) const {
        const long L = (long)i * G + c; if (L >= nwg) return false;
        int wgid = (int)L; { const int q = nwg / NXCD, r = nwg % NXCD, xcd = wgid % NXCD, off = wgid / NXCD; wgid = (xcd < r ? xcd * (q + 1) : r * (q + 1) + (xcd - r) * q) + off; }
        const int nig = WGM * nN, gid = wgid / nig, fm = gid * WGM, gsz = (nM - fm) < WGM ? (nM - fm) : WGM;
        u.pm = fm + ((wgid % nig) % gsz); u.pn = (wgid % nig) / gsz; return true;
    }
    __device__ __forceinline__ void a_ready(const Unit&) const {}
    __device__ __forceinline__ void done(const Unit&) const {}
};

struct AlignedOrder {
    int nN, c;
    __host__ __device__ void init(int N, int c_) { nN = N / BM; c = c_; }
    __host__ __device__ bool next(int i, Unit& u) const {
        const int R = nN >> 2, rem = nN & 3, xcd = c & 7, o = c >> 3;
        if (i < R) { u.pm = 8 * xcd + 4 * (o >> 4) + (o & 3); u.pn = ((o & 15) >> 2) + 4 * i; return true; }
        if (i == R && o < 8 * rem) { u.pm = 8 * xcd + (o & 7); u.pn = 4 * R + (o >> 3); return true; }
        return false;
    }
    __device__ __forceinline__ void a_ready(const Unit&) const {}
    __device__ __forceinline__ void done(const Unit&) const {}
};

__device__ __forceinline__ unsigned cvt_pk_bf16(float lo, float hi) { unsigned r; asm volatile("v_cvt_pk_bf16_f32 %0, %1, %2" : "=v"(r) : "v"(lo), "v"(hi)); return r; }

template <class T, class = void> struct has_pref { static constexpr bool value = false; };
template <class T> struct has_pref<T, decltype((void)T::PREF)> { static constexpr bool value = true; };
__host__ __device__ constexpr int pref_piece(int k) {
    return ((k >> 1) == 0 ? 4 : (k >> 1) == 1 ? 5 : (k >> 1) == 2 ? 0 : (k >> 1) == 3 ? 1 : (k >> 1) == 4 ? 6 : (k >> 1) == 5 ? 7 : 2) * 16384 + (k & 1) * 8192; }
__host__ __device__ constexpr unsigned pref_tile_off(int k, int LD, int ES) { return (unsigned)((((128 * (k >> 3) + 16 * ((k >> 1) & 3)) * LD) + 128 * (k & 1)) * ES); }
__device__ __forceinline__ unsigned pref_tile_lane(int wr, int wc, int fr, int fq, int LD, int ES) { return (unsigned)((((wr * 64 + fr) * LD) + wc * 32 + 8 * fq) * ES); }
template <int N> __device__ __forceinline__ void wait_vmcnt8_or(int relax) {
    asm volatile("s_cmp_eq_u32 %0, 0\n\ts_cbranch_scc0 1\n\ts_waitcnt vmcnt(8)\n\ts_waitcnt vmcnt(%1)" :: "s"(__builtin_amdgcn_readfirstlane(relax)), "n"(N) : "memory", "scc"); }
struct NoHook { static constexpr bool KROT = false; __device__ __forceinline__ int rot(const Unit&) const { return 0; } __device__ __forceinline__ void wait() const {} };
template <class Epi, class Sched, bool ALIGN_EPI = true, bool SP2 = true, int NST = 0, class Hook = NoHook>
__device__ __forceinline__ void gemm_phase(LAS unsigned char* lds, const Gemm g, const Sched& S, const Epi& E, const int wid, const Hook& H = Hook()) {
    const int lane = lane_id(), tid = wid * 64 + lane, wr = wid >> 2, wc = wid & 3, fr = lane & 15, fq = lane >> 4;
    const int K = g.K, nt = K / BK;
    unsigned voffA[2], voffB[2];
#pragma unroll
    for (int i = 0; i < 2; ++i) { int R, C; stage_rc(tid * 16 + i * 8192, R, C); const int Rb = Epi::PERM ? ((R & ~31) + perm32(R & 31)) : R;
        voffA[i] = (unsigned)(R * K + C) * 2u; voffB[i] = (unsigned)(Rb * K + C) * 2u; }
    const size_t kstep = (size_t)(BK * 2);
    const size_t hstep = (size_t)HALF * K * 2;
    const size_t tstep = 2 * hstep;
    const unsigned ldsw = (unsigned)wid * 1024u;
    const int aoff = lds_byte(wr * 64 + fr, fq * 8), boff = lds_byte(wc * 32 + fr, fq * 8);
#define PG8_SA(b, h) (((b) * 2 + (h)) * HTB)
#define PG8_SB(b, h) ((4 + (b) * 2 + (h)) * HTB)
#define PG8_STAGE(bufoff, gbase, voff) do { _Pragma("unroll") for (int _i = 0; _i < 2; ++_i) \
        __builtin_amdgcn_global_load_lds((const unsigned*)((const char*)(gbase) + (voff)[_i]), (LAS unsigned*)(lds + (bufoff) + ldsw + _i * 8192), 16, 0, 0); } while (0)
#define PG8_LDA(dst, b, h) do { _Pragma("unroll") for (int m = 0; m < 4; ++m) _Pragma("unroll") for (int k = 0; k < 2; ++k) dst[m][k] = *(const LAS bf16x8*)(lds + PG8_SA(b, h) + aoff + m * 2048 + k * 1024); } while (0)
#define PG8_LDB(dst, b, h) do { _Pragma("unroll") for (int n = 0; n < 2; ++n) _Pragma("unroll") for (int k = 0; k < 2; ++k) dst[n][k] = *(const LAS bf16x8*)(lds + PG8_SB(b, h) + boff + n * 2048 + k * 1024); } while (0)
#define PG8_MMA(ai, bj, At, Bt) do { __builtin_amdgcn_s_setprio(1); _Pragma("unroll") for (int m = 0; m < 4; ++m) _Pragma("unroll") for (int n = 0; n < 2; ++n) _Pragma("unroll") for (int k = 0; k < 2; ++k) \
        acc[ai][bj][m][n] = __builtin_amdgcn_mfma_f32_16x16x32_bf16(Bt[n][k], At[m][k], acc[ai][bj][m][n], 0, 0, 0); __builtin_amdgcn_s_setprio(0); } while (0)
#define PG8_WAIT_V(n) asm volatile("s_waitcnt vmcnt(" #n ")" ::: "memory")
#define PG8_WAIT_L(n) asm volatile("s_waitcnt lgkmcnt(" #n ")" ::: "memory")
#define PG8_BAR __builtin_amdgcn_s_barrier()
#define PG8_SCHED __builtin_amdgcn_sched_barrier(0)
    Unit cur, nxt; int ui = 0;
    if (!S.next(0, cur)) return;
    f32x4 acc[2][2][4][2];
#pragma unroll
    for (int a = 0; a < 2; ++a)
#pragma unroll
        for (int b = 0; b < 2; ++b)
#pragma unroll
            for (int m = 0; m < 4; ++m)
#pragma unroll
                for (int n = 0; n < 2; ++n) acc[a][b][m][n] = (f32x4){0.f, 0.f, 0.f, 0.f};
    bf16x8 At[4][2], B0[2][2], B1[2][2];
    const char* cA = (const char*)g.A + (size_t)cur.pm * tstep; const char* cB = (const char*)g.Bt + (size_t)cur.pn * tstep;
    int rot = Hook::KROT ? H.rot(cur) : 0;
    S.a_ready(cur);
    if constexpr (SP2) {
        const char* rA = cA + (size_t)rot * kstep; const char* rB = cB + (size_t)rot * kstep;
        PG8_STAGE(PG8_SB(0, 0), rB, voffB); PG8_STAGE(PG8_SB(0, 1), rB + hstep, voffB); PG8_STAGE(PG8_SA(0, 0), rA, voffA); PG8_STAGE(PG8_SA(0, 1), rA + hstep, voffA);
        if (wr == 1) PG8_BAR;
        PG8_WAIT_V(2); PG8_BAR;
        PG8_STAGE(PG8_SB(1, 0), rB + kstep, voffB); PG8_STAGE(PG8_SA(1, 0), rA + kstep, voffA); PG8_STAGE(PG8_SB(1, 1), rB + hstep + kstep, voffB);
        PG8_WAIT_V(6); PG8_BAR;
    } else {
        PG8_STAGE(PG8_SB(0, 0), cB, voffB); PG8_STAGE(PG8_SA(0, 0), cA, voffA); PG8_STAGE(PG8_SB(0, 1), cB + hstep, voffB); PG8_STAGE(PG8_SA(0, 1), cA + hstep, voffA);
        if (wr == 1) PG8_BAR;
        PG8_WAIT_V(4); PG8_BAR;
        PG8_STAGE(PG8_SB(1, 0), cB + kstep, voffB); PG8_STAGE(PG8_SA(1, 0), cA + kstep, voffA); PG8_STAGE(PG8_SB(1, 1), cB + hstep + kstep, voffB);
        PG8_WAIT_V(6); PG8_BAR;
    }
    for (;;) {
        const bool has_next = S.next(ui + 1, nxt);
        const char* nA = has_next ? (const char*)g.A + (size_t)nxt.pm * tstep : cA; const char* nB = has_next ? (const char*)g.Bt + (size_t)nxt.pn * tstep : cB;
        const char* pbase = nullptr;
        if constexpr (has_pref<Epi>::value) { if (!has_next) pbase = E.pref_base(cur); }
        for (int t = 0; t < nt; t += 2) {
            const bool last = (t == nt - 2);
            int tr = t, tr2 = t + 2;
            if constexpr (Hook::KROT) { tr = t + rot; tr = tr >= nt ? tr - nt : tr; tr2 = tr + 2; tr2 = tr2 >= nt ? tr2 - nt : tr2; }
            const char* a1 = cA + (size_t)(tr + 1) * kstep;
            const char* a2 = last ? nA : cA + (size_t)tr2 * kstep; const char* b2 = last ? nB : cB + (size_t)tr2 * kstep;
            const char* a3 = a2 + kstep; const char* b3 = b2 + kstep;
            if (last && has_next) S.a_ready(nxt);
            const bool pref = has_pref<Epi>::value && last && (pbase != nullptr);
            unsigned plo = 0u;
            if constexpr (has_pref<Epi>::value) { const int l_ = lane_id(); plo = Epi::pref_lane(wr, wc, l_ & 15, l_ >> 4); }
#define PG8_STAGE_P(bufoff, gbase, voff, j0) do { if constexpr (has_pref<Epi>::value) { const char* gb_ = pref ? pbase : (const char*)(gbase); \
                _Pragma("unroll") for (int _i = 0; _i < 2; ++_i) { const unsigned vo_ = pref ? plo + Epi::pref_off((j0) + _i) : (voff)[_i]; \
                    __builtin_amdgcn_global_load_lds((const unsigned*)(gb_ + vo_), (LAS unsigned*)(lds + (bufoff) + ldsw + _i * 8192), 16, 0, 0); } } \
            else PG8_STAGE(bufoff, gbase, voff); } while (0)
            if constexpr (SP2) {
            const int relax = ((NST > 0) && (t == 0) && (ui > 0)) ? 1 : 0;
            PG8_LDB(B0, 0, 0); PG8_LDB(B1, 0, 1); PG8_SCHED; PG8_LDA(At, 0, 0); PG8_STAGE(PG8_SA(1, 1), a1 + hstep, voffA);
            if constexpr (NST > 0) wait_vmcnt8_or<8 + NST>(relax); else PG8_WAIT_V(8);
            PG8_WAIT_L(0); PG8_BAR; PG8_MMA(0, 0, At, B0); PG8_MMA(0, 1, At, B1); PG8_BAR; PG8_SCHED;
            if constexpr (Hook::KROT) { if (t == 2 && ui == 0) H.wait(); }
            PG8_LDA(At, 0, 1); PG8_STAGE_P(PG8_SB(0, 0), b2, voffB, 0); PG8_STAGE_P(PG8_SB(0, 1), b2 + hstep, voffB, 2); PG8_STAGE_P(PG8_SA(0, 0), a2, voffA, 4);
            if constexpr (NST > 0) wait_vmcnt8_or<8 + NST>(relax); else PG8_WAIT_V(8);
            PG8_WAIT_L(0); PG8_BAR; PG8_MMA(1, 0, At, B0); PG8_MMA(1, 1, At, B1); PG8_BAR; PG8_SCHED;
            PG8_LDB(B0, 1, 0); PG8_LDB(B1, 1, 1); PG8_SCHED; PG8_LDA(At, 1, 0); PG8_STAGE_P(PG8_SA(0, 1), a2 + hstep, voffA, 6);
            PG8_WAIT_V(8); PG8_WAIT_L(0); PG8_BAR; PG8_MMA(0, 0, At, B0); PG8_MMA(0, 1, At, B1); PG8_BAR; PG8_SCHED;
            PG8_LDA(At, 1, 1); PG8_STAGE_P(PG8_SB(1, 0), b3, voffB, 8); PG8_STAGE_P(PG8_SB(1, 1), b3 + hstep, voffB, 10); PG8_STAGE_P(PG8_SA(1, 0), a3, voffA, 12);
            PG8_WAIT_V(8); PG8_WAIT_L(0); PG8_BAR; PG8_MMA(1, 0, At, B0); PG8_MMA(1, 1, At, B1); PG8_BAR; PG8_SCHED;
            } else {
            PG8_LDB(B0, 0, 0); PG8_SCHED; PG8_LDA(At, 0, 0); PG8_STAGE(PG8_SA(1, 1), a1 + hstep, voffA);
            PG8_WAIT_L(8); PG8_BAR; PG8_WAIT_L(0); PG8_MMA(0, 0, At, B0); PG8_BAR; PG8_SCHED;
            PG8_LDB(B1, 0, 1); PG8_STAGE(PG8_SB(0, 0), b2, voffB);
            PG8_BAR; PG8_WAIT_L(0); PG8_MMA(0, 1, At, B1); PG8_BAR;
            PG8_LDA(At, 0, 1); PG8_STAGE(PG8_SA(0, 0), a2, voffA);
            PG8_BAR; PG8_WAIT_L(0); PG8_MMA(1, 0, At, B0); PG8_BAR; PG8_SCHED;
            PG8_STAGE(PG8_SB(0, 1), b2 + hstep, voffB);
            PG8_WAIT_V(6); PG8_BAR; PG8_MMA(1, 1, At, B1); PG8_BAR;
            PG8_LDB(B0, 1, 0); PG8_SCHED; PG8_LDA(At, 1, 0); PG8_STAGE(PG8_SA(0, 1), a2 + hstep, voffA);
            PG8_WAIT_L(8); PG8_BAR; PG8_WAIT_L(0); PG8_MMA(0, 0, At, B0); PG8_BAR; PG8_SCHED;
            PG8_LDB(B1, 1, 1); PG8_STAGE(PG8_SB(1, 0), b3, voffB);
            PG8_BAR; PG8_WAIT_L(0); PG8_MMA(0, 1, At, B1); PG8_BAR;
            PG8_LDA(At, 1, 1); PG8_STAGE(PG8_SA(1, 0), a3, voffA);
            PG8_BAR; PG8_WAIT_L(0); PG8_MMA(1, 0, At, B0); PG8_BAR; PG8_SCHED;
            PG8_STAGE(PG8_SB(1, 1), b3 + hstep, voffB);
            PG8_WAIT_V(6); PG8_BAR; PG8_MMA(1, 1, At, B1); PG8_BAR;
            }
        }
        if constexpr (ALIGN_EPI) { if (wr == 0) PG8_BAR; }
        E(acc, cur, wr, wc, fr, fq); S.done(cur);
        if (!has_next) break;
#pragma unroll
        for (int a = 0; a < 2; ++a)
#pragma unroll
            for (int b = 0; b < 2; ++b)
#pragma unroll
                for (int m = 0; m < 4; ++m)
#pragma unroll
                    for (int n = 0; n < 2; ++n) acc[a][b][m][n] = (f32x4){0.f, 0.f, 0.f, 0.f};
        cur = nxt; cA = nA; cB = nB; ++ui; if constexpr (Hook::KROT) rot = 0;
        if constexpr (ALIGN_EPI) { if (wr == 1) PG8_BAR; }
    }
    PG8_WAIT_V(0);
    if constexpr (!ALIGN_EPI) { if (wr == 0) PG8_BAR; }
    PG8_BAR;
#undef PG8_SA
#undef PG8_SB
#undef PG8_STAGE
#undef PG8_STAGE_P
#undef PG8_LDA
#undef PG8_LDB
#undef PG8_MMA
#undef PG8_WAIT_V
#undef PG8_WAIT_L
#undef PG8_BAR
#undef PG8_SCHED
}

__device__ __forceinline__ float row_rs(const float* rss, int row, int fq) {
    const f32x4 p = *(const f32x4*)(rss + (size_t)row * 16 + 4 * fq);
    float s = (p[0] + p[1]) + (p[2] + p[3]);
    s = rows4_sum(s);
    return __builtin_amdgcn_rsqf(s * (1.0f / DM) + EPS);
}

struct EpiSwiglu {
    static constexpr bool PERM = true;
    bf16_t* H; const float* rss;
    __device__ __forceinline__ void operator()(const f32x4 (&acc)[2][2][4][2], const Unit& u, int wr, int wc, int fr, int fq) const {
        const int row0 = u.pm * BM + wr * 64 + fr, col0 = u.pn * HALF + wc * 32 + 8 * fq;
        float rsv[2][4];
#pragma unroll
        for (int ai = 0; ai < 2; ++ai)
#pragma unroll
            for (int m = 0; m < 4; ++m) rsv[ai][m] = rss ? row_rs(rss, row0 + ai * HALF + m * 16, fq) : 1.0f;
#pragma unroll
        for (int ai = 0; ai < 2; ++ai)
#pragma unroll
            for (int m = 0; m < 4; ++m) {
                const int row = row0 + ai * HALF + m * 16;
                const float rs = rsv[ai][m];
                const f32x4 g0 = acc[ai][0][m][0] * rs, g1 = acc[ai][0][m][1] * rs, u0 = acc[ai][1][m][0] * rs, u1 = acc[ai][1][m][1] * rs;
                float h[8];
#pragma unroll
                for (int j = 0; j < 4; ++j) { h[j] = siluf_(g0[j]) * u0[j]; h[4 + j] = siluf_(g1[j]) * u1[j]; }
                u32x4 w; w.x = cvt_pk_bf16(h[0], h[1]); w.y = cvt_pk_bf16(h[2], h[3]); w.z = cvt_pk_bf16(h[4], h[5]); w.w = cvt_pk_bf16(h[6], h[7]);
                *(u32x4*)(H + (size_t)row * FF + col0) = w;
            }
    }
};

struct EpiResid {
    static constexpr bool PERM = true, PREF = true;
    const float* X; bf16_t* HI; float* rss; float alpha; LAS unsigned char* plds;
    __device__ __forceinline__ const char* pref_base(const Unit& u) const { return (const char*)(X + ((size_t)u.pm * BM * DM + (size_t)u.pn * BM)); }
    static __device__ __forceinline__ unsigned pref_lane(int wr, int wc, int fr, int fq) { return pref_tile_lane(wr, wc, fr, fq, 1024, 4); }
    static constexpr unsigned pref_off(int j) { return pref_tile_off(j >> 1, 1024, 4) + 16u * (unsigned)(j & 1); }
    __device__ __forceinline__ void operator()(const f32x4 (&acc)[2][2][4][2], const Unit& u, int wr, int wc, int, int) const {
        const int lane_ = lane_id(), fr = lane_ & 15, fq = lane_ >> 4;
        const int row0 = u.pm * BM + wr * 64 + fr, col0 = u.pn * BM + wc * 32 + 8 * fq;
        const LAS unsigned char* mine = plds + (wr * 4 + wc) * 1024 + lane_ * 16;
        asm volatile("s_waitcnt vmcnt(0)" ::: "memory");
#pragma unroll
        for (int ai = 0; ai < 2; ++ai)
#pragma unroll
            for (int m = 0; m < 4; ++m) {
                const int row = row0 + ai * HALF + m * 16; float ss = 0.f;
#pragma unroll
                for (int bj = 0; bj < 2; ++bj) {
                    const size_t off = (size_t)row * DM + col0 + bj * HALF;
                    const int k = ai * 8 + m * 2 + bj;
                    f32x4 x0, x1;
                    if (2 * k < 14) x0 = *(const LAS f32x4*)(mine + pref_piece(2 * k)); else x0 = *(const f32x4*)(X + off);
                    if (2 * k + 1 < 14) x1 = *(const LAS f32x4*)(mine + pref_piece(2 * k + 1)); else x1 = *(const f32x4*)(X + off + 4);
                    float v[8];
#pragma unroll
                    for (int j = 0; j < 4; ++j) { v[j] = x0[j] + alpha * acc[ai][bj][m][0][j]; v[4 + j] = x1[j] + alpha * acc[ai][bj][m][1][j]; }
                    u32x4 hw;
#pragma unroll
                    for (int j = 0; j < 4; ++j) {
                        hw[j] = cvt_pk_bf16(v[2 * j], v[2 * j + 1]);
                        ss += v[2 * j] * v[2 * j] + v[2 * j + 1] * v[2 * j + 1];
                    }
                    *(u32x4*)(HI + off) = hw;
                }
                ss = rows4_sum(ss);
                if (fq == 0) rss[(size_t)row * 16 + 4 * u.pn + wc] = ss;
            }
    }
};

struct EpiResidH {
    static constexpr bool PERM = true, PREF = true;
    bf16_t* HI; float* rss; float alpha; LAS unsigned char* plds; const float* bscale;
    __device__ __forceinline__ const char* pref_base(const Unit& u) const { return (const char*)(HI + ((size_t)u.pm * BM * DM + (size_t)u.pn * BM)); }
    static __device__ __forceinline__ unsigned pref_lane(int wr, int wc, int fr, int fq) { return pref_tile_lane(wr, wc, fr, fq, 1024, 2); }
    static constexpr unsigned pref_off(int j) { return pref_tile_off(j, 1024, 2); }
    __device__ __forceinline__ void operator()(const f32x4 (&acc)[2][2][4][2], const Unit& u, int wr, int wc, int, int) const {
        const int lane_ = lane_id(), fr = lane_ & 15, fq = lane_ >> 4;
        const int row0 = u.pm * BM + wr * 64 + fr, col0 = u.pn * BM + wc * 32 + 8 * fq;
        const LAS unsigned char* mine = plds + (wr * 4 + wc) * 1024 + lane_ * 16;
        float bsv[2][4];
#pragma unroll
        for (int ai = 0; ai < 2; ++ai)
#pragma unroll
            for (int m = 0; m < 4; ++m) bsv[ai][m] = bscale ? bscale[row0 + ai * HALF + m * 16] : 1.0f;
        const size_t off14 = (size_t)(row0 + HALF + 48) * DM + col0;
        const u32x4 bw14 = *(const u32x4*)(HI + off14), bw15 = *(const u32x4*)(HI + off14 + HALF);
        asm volatile("s_waitcnt vmcnt(0)" ::: "memory");
#pragma unroll
        for (int ai = 0; ai < 2; ++ai)
#pragma unroll
            for (int m = 0; m < 4; ++m) {
                const int row = row0 + ai * HALF + m * 16; float ss = 0.f;
                const float bs = bsv[ai][m];
#pragma unroll
                for (int bj = 0; bj < 2; ++bj) {
                    const size_t off = (size_t)row * DM + col0 + bj * HALF;
                    const int k = ai * 8 + m * 2 + bj;
                    u32x4 bw;
                    if (k < 14) bw = *(const LAS u32x4*)(mine + pref_piece(k)); else bw = (k == 14) ? bw14 : bw15;
                    float v[8];
#pragma unroll
                    for (int j = 0; j < 2; ++j) {
                        v[2 * j]     = bflo(bw[j]) * bs     + alpha * acc[ai][bj][m][0][2 * j];     v[2 * j + 1]     = bfhi(bw[j]) * bs     + alpha * acc[ai][bj][m][0][2 * j + 1];
                        v[4 + 2 * j] = bflo(bw[2 + j]) * bs + alpha * acc[ai][bj][m][1][2 * j];     v[4 + 2 * j + 1] = bfhi(bw[2 + j]) * bs + alpha * acc[ai][bj][m][1][2 * j + 1]; }
                    u32x4 hw;
#pragma unroll
                    for (int j = 0; j < 4; ++j) { hw[j] = cvt_pk_bf16(v[2 * j], v[2 * j + 1]); ss += v[2 * j] * v[2 * j] + v[2 * j + 1] * v[2 * j + 1]; }
                    *(u32x4*)(HI + off) = hw;
                }
                ss = rows4_sum(ss);
                if (fq == 0) rss[(size_t)row * 16 + 4 * u.pn + wc] = ss;
            }
    }
};

struct EpiInproj {
    static constexpr bool PERM = true;
    unsigned char* ws; bf16_t* gates; const float* rss; const float* ckv_g; LAS unsigned char* lds;
    __device__ __forceinline__ void operator()(const f32x4 (&acc)[2][2][4][2], const Unit& u, int wr, int wc, int fr, int fq) const {
        const int row0 = u.pm * BM + wr * 64 + fr;
        const int pn = u.pn;
        if (pn < 26) {
            bf16_t* dst; int ld, ct; float sc = 1.0f;
            if (pn < 2)       { dst = (bf16_t*)(ws + WS_GQ); ld = 512;  ct = pn;      sc = 0.08838834764831845f; }
            else if (pn < 4)  { dst = (bf16_t*)(ws + WS_GK); ld = 512;  ct = pn - 2; }
            else if (pn < 8)  { dst = (bf16_t*)(ws + WS_GV); ld = 1024; ct = pn - 4; }
            else if (pn < 12) { dst = (bf16_t*)(ws + WS_GR); ld = 1024; ct = pn - 8; }
            else if (pn < 16) { dst = (bf16_t*)(ws + WS_DQ); ld = 1024; ct = pn - 12; }
            else if (pn < 18) { dst = (bf16_t*)(ws + WS_IQ); ld = 512;  ct = pn - 16; }
            else              { dst = gates;                 ld = 2048; ct = pn - 18; }
            const int col0 = ct * BM + wc * 32 + 8 * fq;
#pragma unroll
            for (int ai = 0; ai < 2; ++ai)
#pragma unroll
                for (int m = 0; m < 4; ++m) {
                    const int row = row0 + ai * HALF + m * 16;
                    const float rs = row_rs(rss, row, fq) * sc;
#pragma unroll
                    for (int bj = 0; bj < 2; ++bj) {
                        const f32x4 v0 = acc[ai][bj][m][0] * rs, v1 = acc[ai][bj][m][1] * rs;
                        u32x4 w; w.x = cvt_pk_bf16(v0[0], v0[1]); w.y = cvt_pk_bf16(v0[2], v0[3]); w.z = cvt_pk_bf16(v1[0], v1[1]); w.w = cvt_pk_bf16(v1[2], v1[3]);
                        *(u32x4*)(dst + (size_t)row * ld + col0 + bj * HALF) = w;
                    }
                }
        } else {
            LAS float* red = (LAS float*)(lds + LDS_EPI);
            float rsv[2][4];
#pragma unroll
            for (int ai = 0; ai < 2; ++ai)
#pragma unroll
                for (int m = 0; m < 4; ++m) {
                    const int row = row0 + ai * HALF + m * 16;
                    const float rs = row_rs(rss, row, fq); rsv[ai][m] = rs;
                    const f32x4 v0 = acc[ai][0][m][0] * rs, v1 = acc[ai][0][m][1] * rs;
                    float ss = (v0[0] * v0[0] + v0[1] * v0[1]) + (v0[2] * v0[2] + v0[3] * v0[3]) + (v1[0] * v1[0] + v1[1] * v1[1]) + (v1[2] * v1[2] + v1[3] * v1[3]);
                    ss = rows4_sum(ss);
                    if (fq == 0) red[(wr * 64 + fr + ai * HALF + m * 16) * 4 + wc] = ss;
                }
            asm volatile("s_waitcnt lgkmcnt(0)" ::: "memory"); __builtin_amdgcn_s_barrier(); asm volatile("" ::: "memory");
            bf16_t* CKV = (bf16_t*)(ws + WS_CKV); bf16_t* IK = (bf16_t*)(ws + WS_IK); float* IW = (float*)(ws + WS_IW); float* GA = (float*)(ws + WS_GA);
            const int c0 = wc * 32 + 8 * fq;
            const f32x4 g0 = *(const f32x4*)(ckv_g + c0), g1 = *(const f32x4*)(ckv_g + c0 + 4);
#pragma unroll
            for (int ai = 0; ai < 2; ++ai)
#pragma unroll
                for (int m = 0; m < 4; ++m) {
                    const int rl = wr * 64 + fr + ai * HALF + m * 16; const int row = u.pm * BM + rl; const float rs = rsv[ai][m];
                    const f32x4 t4 = *(const LAS f32x4*)(red + rl * 4);
                    const float rstd = __builtin_amdgcn_rsqf(((t4[0] + t4[1]) + (t4[2] + t4[3])) * (1.0f / 128.0f) + EPS);
                    { const f32x4 v0 = acc[ai][0][m][0] * (rs * rstd) * g0, v1 = acc[ai][0][m][1] * (rs * rstd) * g1;
                      u32x4 w; w.x = cvt_pk_bf16(v0[0], v0[1]); w.y = cvt_pk_bf16(v0[2], v0[3]); w.z = cvt_pk_bf16(v1[0], v1[1]); w.w = cvt_pk_bf16(v1[2], v1[3]);
                      *(u32x4*)(CKV + (size_t)row * 128 + c0) = w; }
                    const f32x4 v0 = acc[ai][1][m][0] * rs, v1 = acc[ai][1][m][1] * rs;
                    if (wc < 2) { u32x4 w; w.x = cvt_pk_bf16(v0[0], v0[1]); w.y = cvt_pk_bf16(v0[2], v0[3]); w.z = cvt_pk_bf16(v1[0], v1[1]); w.w = cvt_pk_bf16(v1[2], v1[3]);
                        *(u32x4*)(IK + (size_t)row * 64 + c0) = w; }
                    else if (wc == 2 && fq < 2) { *(f32x4*)(GA + (size_t)row * 16 + 8 * fq) = v0; *(f32x4*)(GA + (size_t)row * 16 + 8 * fq + 4) = v1; }
                    else if (wc == 2 && fq == 2) { *(f32x4*)(IW + (size_t)row * 8) = v0; *(f32x4*)(IW + (size_t)row * 8 + 4) = v1; }
                }
            asm volatile("s_waitcnt lgkmcnt(0)" ::: "memory"); __builtin_amdgcn_s_barrier(); asm volatile("" ::: "memory");
        }
    }
};

struct EpiMerge {
    static constexpr bool PERM = true, PREF = true;
    bf16_t* MG; const bf16_t* gates; int pass; LAS unsigned char* plds;
    __device__ __forceinline__ const char* pref_base(const Unit& u) const { return (const char*)(gates + ((size_t)u.pm * BM * 2048 + (size_t)pass * 1024 + (size_t)u.pn * BM)); }
    static __device__ __forceinline__ unsigned pref_lane(int wr, int wc, int fr, int fq) { return pref_tile_lane(wr, wc, fr, fq, 2048, 2); }
    static constexpr unsigned pref_off(int j) { return pref_tile_off(j, 2048, 2); }
    __device__ __forceinline__ void operator()(const f32x4 (&acc)[2][2][4][2], const Unit& u, int wr, int wc, int, int) const {
        const int lane_ = lane_id(), fr = lane_ & 15, fq = lane_ >> 4;
        const int row0 = u.pm * BM + wr * 64 + fr, col0 = u.pn * BM + wc * 32 + 8 * fq;
        const LAS unsigned char* mine = plds + (wr * 4 + wc) * 1024 + lane_ * 16;
        asm volatile("s_waitcnt vmcnt(0)" ::: "memory");
#pragma unroll
        for (int ai = 0; ai < 2; ++ai)
#pragma unroll
            for (int m = 0; m < 4; ++m) {
                const int row = row0 + ai * HALF + m * 16;
#pragma unroll
                for (int bj = 0; bj < 2; ++bj) {
                    const int col = col0 + bj * HALF;
                    const int k = ai * 8 + m * 2 + bj;
                    u32x4 gw;
                    if (k < 14) gw = *(const LAS u32x4*)(mine + pref_piece(k)); else gw = *(const u32x4*)(gates + (size_t)row * 2048 + pass * 1024 + col);
                    float v[8];
#pragma unroll
                    for (int j = 0; j < 4; ++j) { v[j] = acc[ai][bj][m][0][j]; v[4 + j] = acc[ai][bj][m][1][j]; }
#pragma unroll
                    for (int j = 0; j < 4; ++j) { v[2 * j] *= sigmoidf_(bflo(gw[j])); v[2 * j + 1] *= sigmoidf_(bfhi(gw[j])); }
                    if (pass) { const u32x4 pw = *(const u32x4*)(MG + (size_t)row * DM + col);
#pragma unroll
                        for (int j = 0; j < 4; ++j) { v[2 * j] += bflo(pw[j]); v[2 * j + 1] += bfhi(pw[j]); } }
                    u32x4 w; w.x = cvt_pk_bf16(v[0], v[1]); w.y = cvt_pk_bf16(v[2], v[3]); w.z = cvt_pk_bf16(v[4], v[5]); w.w = cvt_pk_bf16(v[6], v[7]);
                    *(u32x4*)(MG + (size_t)row * DM + col) = w;
                }
            }
    }
};

__device__ __forceinline__ unsigned cvt_pk_bf16_nv(float lo, float hi) { unsigned r; asm("v_cvt_pk_bf16_f32 %0, %1, %2" : "=v"(r) : "v"(lo), "v"(hi)); return r; }
struct EpiPle {
    static constexpr bool PERM = true;
    bf16_t* PROJ;
    __device__ __forceinline__ void operator()(const f32x4 (&acc)[2][2][4][2], const Unit& u, int wr, int wc, int, int) const {
        const int lane_ = lane_id(), fr = lane_ & 15, fq = lane_ >> 4;
        const int row0 = u.pm * BM + wr * 64 + fr, col0 = u.pn * BM + wc * 32 + 8 * fq;
#pragma unroll
        for (int ai = 0; ai < 2; ++ai)
#pragma unroll
            for (int m = 0; m < 4; ++m) {
                const int row = row0 + ai * HALF + m * 16;
#pragma unroll
                for (int bj = 0; bj < 2; ++bj) { const size_t off = (size_t)row * DM + col0 + bj * HALF;
                    const f32x4 c0 = acc[ai][bj][m][0], c1 = acc[ai][bj][m][1];
                    u32x4 w; w.x = cvt_pk_bf16_nv(c0[0], c0[1]); w.y = cvt_pk_bf16_nv(c0[2], c0[3]); w.z = cvt_pk_bf16_nv(c1[0], c1[1]); w.w = cvt_pk_bf16_nv(c1[2], c1[3]);
                    *(u32x4*)(PROJ + off) = w; }
            }
    }
};

struct EpiPleFinal {
    static constexpr bool PERM = true, PREF = true;
    float* OUT; const bf16_t* HI; const bf16_t* PROJ; const float* rss_in; const float* gfin; unsigned* xbuf; unsigned* cnt; unsigned* tmo; LAS unsigned char* lds;
    __device__ __forceinline__ const char* pref_base(const Unit& u) const { return (const char*)(HI + ((size_t)u.pm * BM * DM + (size_t)u.pn * BM)); }
    static __device__ __forceinline__ unsigned pref_lane(int wr, int wc, int fr, int fq) { return pref_tile_lane(wr, wc, fr, fq, 1024, 2); }
    static constexpr unsigned pref_off(int j) { return pref_tile_off(j, 1024, 2); }
    __device__ __forceinline__ void operator()(f32x4 (&acc)[2][2][4][2], const Unit& u, int wr, int wc, int fr, int fq) const {
        const int row0 = u.pm * BM + wr * 64 + fr, col0 = u.pn * BM + wc * 32 + 8 * fq;
        LAS float* P = (LAS float*)(lds + LDS_EPI); LAS float* S = P + 1024; LAS unsigned* flag = (LAS unsigned*)(S + 256);
        const LAS unsigned char* mine = lds + (wr * 4 + wc) * 1024 + (fr + 16 * fq) * 16;
        f32x4 rp[2][4];
#pragma unroll
        for (int ai = 0; ai < 2; ++ai)
#pragma unroll
            for (int m = 0; m < 4; ++m) rp[ai][m] = *(const f32x4*)(rss_in + (size_t)(row0 + ai * HALF + m * 16) * 16 + 4 * fq);
        asm volatile("s_waitcnt vmcnt(0)" ::: "memory");
        float rsv[2][4];
#pragma unroll
        for (int ai = 0; ai < 2; ++ai)
#pragma unroll
            for (int m = 0; m < 4; ++m) rsv[ai][m] = __builtin_amdgcn_rsqf(rows4_sum((rp[ai][m][0] + rp[ai][m][1]) + (rp[ai][m][2] + rp[ai][m][3])) * (1.0f / DM) + EPS);
#pragma unroll
        for (int ai = 0; ai < 2; ++ai)
#pragma unroll
            for (int m = 0; m < 4; ++m) {
                const int row = row0 + ai * HALF + m * 16;
                const float rs = rsv[ai][m]; float ss = 0.f;
#pragma unroll
                for (int bj = 0; bj < 2; ++bj) { const size_t off = (size_t)row * DM + col0 + bj * HALF;
                    const u32x4 pw = *(const u32x4*)(PROJ + off);
                    const int k = ai * 8 + m * 2 + bj;
                    u32x4 hw;
                    if (k < 14) hw = *(const LAS u32x4*)(mine + pref_piece(k)); else hw = *(const u32x4*)(HI + off);
                    f32x4 o0, o1;
#pragma unroll
                    for (int j = 0; j < 2; ++j) {
                        o0[2 * j]     = bflo(hw[j])     + sigmoidf_(rs * acc[ai][bj][m][0][2 * j])     * bflo(pw[j]);
                        o0[2 * j + 1] = bfhi(hw[j])     + sigmoidf_(rs * acc[ai][bj][m][0][2 * j + 1]) * bfhi(pw[j]);
                        o1[2 * j]     = bflo(hw[2 + j]) + sigmoidf_(rs * acc[ai][bj][m][1][2 * j])     * bflo(pw[2 + j]);
                        o1[2 * j + 1] = bfhi(hw[2 + j]) + sigmoidf_(rs * acc[ai][bj][m][1][2 * j + 1]) * bfhi(pw[2 + j]); }
#pragma unroll
                    for (int j = 0; j < 4; ++j) ss += o0[j] * o0[j] + o1[j] * o1[j];
                    acc[ai][bj][m][0] = o0; acc[ai][bj][m][1] = o1; }
                ss = rows4_sum(ss);
                if (fq == 0) P[(wr * 64 + fr + ai * HALF + m * 16) * 4 + wc] = ss;
            }
        asm volatile("s_waitcnt lgkmcnt(0)" ::: "memory"); __builtin_amdgcn_s_barrier(); asm volatile("" ::: "memory");
        const int wid = wr * 4 + wc, lane = fr + 16 * fq, rowl = wid * 32 + (lane & 31);
        if (lane < 32) { const f32x4 t4 = *(const LAS f32x4*)(P + rowl * 4);
            __hip_atomic_store(xbuf + ((size_t)(u.pm * BM + rowl) * 4 + u.pn), __builtin_bit_cast(unsigned, (t4[0] + t4[1]) + (t4[2] + t4[3])), __ATOMIC_RELAXED, __HIP_MEMORY_SCOPE_AGENT); }
        asm volatile("s_waitcnt vmcnt(0)" ::: "memory");
        if (lane == 0) __hip_atomic_fetch_add(cnt + 64 * u.pm, 1u, __ATOMIC_RELAXED, __HIP_MEMORY_SCOPE_AGENT);
        if (wid == 0) { unsigned sp = 0; bool dead = false;
            while ((unsigned)__builtin_amdgcn_readfirstlane(__hip_atomic_load(cnt + 64 * u.pm, __ATOMIC_RELAXED, __HIP_MEMORY_SCOPE_AGENT)) < 32u) {
                __builtin_amdgcn_s_sleep(2); if (++sp > (1u << 22)) { dead = true; break; } }
            __builtin_amdgcn_fence(__ATOMIC_ACQUIRE, "agent");
            if (lane == 0) { flag[0] = dead ? 1u : 0u; if (dead) atomicAdd(tmo, 1u); } }
        asm volatile("s_waitcnt vmcnt(0) lgkmcnt(0)" ::: "memory"); __builtin_amdgcn_s_barrier(); asm volatile("" ::: "memory");
        if (lane < 32) { float tot = 0.f;
#pragma unroll
            for (int t = 0; t < 4; ++t) tot += __builtin_bit_cast(float, __hip_atomic_load(xbuf + ((size_t)(u.pm * BM + rowl) * 4 + t), __ATOMIC_RELAXED, __HIP_MEMORY_SCOPE_AGENT));
            S[rowl] = __builtin_amdgcn_rsqf(tot * (1.0f / DM) + EPS); }
        asm volatile("s_waitcnt lgkmcnt(0)" ::: "memory"); __builtin_amdgcn_s_barrier(); asm volatile("" ::: "memory");
        f32x4 gv[2][2];
#pragma unroll
        for (int bj = 0; bj < 2; ++bj) { gv[bj][0] = *(const f32x4*)(gfin + col0 + bj * HALF); gv[bj][1] = *(const f32x4*)(gfin + col0 + bj * HALF + 4); }
#pragma unroll
        for (int ai = 0; ai < 2; ++ai)
#pragma unroll
            for (int m = 0; m < 4; ++m) { const int rl = wr * 64 + fr + ai * HALF + m * 16; const float sr = S[rl];
#pragma unroll
                for (int bj = 0; bj < 2; ++bj) { const size_t off = (size_t)(u.pm * BM + rl) * DM + col0 + bj * HALF;
                    *(f32x4*)(OUT + off) = acc[ai][bj][m][0] * sr * gv[bj][0]; *(f32x4*)(OUT + off + 4) = acc[ai][bj][m][1] * sr * gv[bj][1]; } }
    }
};
}

__device__ __forceinline__ int map_col(int mode, int n) {
    if (mode == 0) return n;
    if (mode == 1) {
        if (n < FF) return 256 * (n >> 7) + (n & 127);
        const int q = n - FF; return 256 * (q >> 7) + 128 + (q & 127);
    }
    if (n < 3072) return n;
    if (n < 3088) return 6848 + (n - 3072);
    if (n < 4112) return 3072 + (n - 3088);
    if (n < 4240) return 6656 + (n - 4112);
    if (n < 4752) return 4096 + (n - 4240);
    if (n < 4816) return 6784 + (n - 4752);
    if (n < 4824) return 6864 + (n - 4816);
    return 4608 + (n - 4824);
}
__device__ __forceinline__ void transpose_item(const float* W, int K, int N, bf16_t* WT, const float* gain, int mode, LAS float* scr, int item, int lane) {
    const int nblk = (N + 31) / 32, kb = item / nblk, nb = item % nblk, k0 = 64 * kb, n0 = 32 * nb;
    const int nn = n0 + (lane & 31);
    float v[32];
    const float* wp = W + (size_t)(k0 + (lane >> 5)) * N + nn;
#pragma unroll
    for (int i = 0; i < 32; ++i) v[i] = (nn < N) ? wp[(size_t)(2 * i) * N] : 0.f;
#pragma unroll
    for (int i = 0; i < 32; ++i) scr[(2 * i + (lane >> 5)) * 33 + (lane & 31)] = v[i];
    asm volatile("s_waitcnt lgkmcnt(0)" ::: "memory");
    const int c = lane & 7;
    f32x4 g0 = (f32x4){1.f, 1.f, 1.f, 1.f}, g1 = g0;
    if (gain) { g0 = *(const f32x4*)(gain + k0 + 8 * c); g1 = *(const f32x4*)(gain + k0 + 8 * c + 4); }
#pragma unroll
    for (int j = 0; j < 4; ++j) { const int nl = (lane >> 3) + 8 * j; const int n = n0 + nl; const LAS float* s = scr + (8 * c) * 33 + nl;
        u32x4 o; o.x = pg8::cvt_pk_bf16(s[0 * 33] * g0[0], s[1 * 33] * g0[1]); o.y = pg8::cvt_pk_bf16(s[2 * 33] * g0[2], s[3 * 33] * g0[3]);
        o.z = pg8::cvt_pk_bf16(s[4 * 33] * g1[0], s[5 * 33] * g1[1]); o.w = pg8::cvt_pk_bf16(s[6 * 33] * g1[2], s[7 * 33] * g1[3]);
        if (n < N) *(u32x4*)(WT + (size_t)map_col(mode, n) * K + k0 + 8 * c) = o; }
    asm volatile("s_waitcnt lgkmcnt(0)" ::: "memory");
}

__device__ __forceinline__ void transpose_pair(const float* W, int K, int N, bf16_t* WT, const float* gain, int mode, LAS float* scr, int itemA, int itemB, int lane) {
    const int nblk = (N + 31) / 32;
    float v[2][32]; int k0[2], n0[2];
#pragma unroll
    for (int t = 0; t < 2; ++t) { const int item = t ? itemB : itemA; const int kb = item / nblk, nb = item % nblk; k0[t] = 64 * kb; n0[t] = 32 * nb;
        const int nn = n0[t] + (lane & 31);
        const float* wp = W + (size_t)(k0[t] + (lane >> 5)) * N + nn;
#pragma unroll
        for (int i = 0; i < 32; ++i) v[t][i] = (nn < N) ? wp[(size_t)(2 * i) * N] : 0.f; }
#pragma unroll
    for (int t = 0; t < 2; ++t) { LAS float* sc = scr + t * 2112;
#pragma unroll
        for (int i = 0; i < 32; ++i) sc[(2 * i + (lane >> 5)) * 33 + (lane & 31)] = v[t][i];
        asm volatile("s_waitcnt lgkmcnt(0)" ::: "memory");
        const int c = lane & 7;
        f32x4 g0 = (f32x4){1.f, 1.f, 1.f, 1.f}, g1 = g0;
        if (gain) { g0 = *(const f32x4*)(gain + k0[t] + 8 * c); g1 = *(const f32x4*)(gain + k0[t] + 8 * c + 4); }
#pragma unroll
        for (int j = 0; j < 4; ++j) { const int nl = (lane >> 3) + 8 * j; const int n = n0[t] + nl; const LAS float* s = sc + (8 * c) * 33 + nl;
            u32x4 o; o.x = pg8::cvt_pk_bf16(s[0 * 33] * g0[0], s[1 * 33] * g0[1]); o.y = pg8::cvt_pk_bf16(s[2 * 33] * g0[2], s[3 * 33] * g0[3]);
            o.z = pg8::cvt_pk_bf16(s[4 * 33] * g1[0], s[5 * 33] * g1[1]); o.w = pg8::cvt_pk_bf16(s[6 * 33] * g1[2], s[7 * 33] * g1[3]);
            if (n < N) *(u32x4*)(WT + (size_t)map_col(mode, n) * K + k0[t] + 8 * c) = o; } }
    asm volatile("s_waitcnt lgkmcnt(0)" ::: "memory");
}

typedef short v4i16_t __attribute__((ext_vector_type(4)));
__device__ __forceinline__ float logsigmoidf_(float x) { return fminf(x, 0.f) - __logf(1.0f + __expf(-fabsf(x))); }
__device__ __forceinline__ int swz(int r) { return ((r & 3) << 2) | ((r >> 2) & 3); }
__device__ __forceinline__ int swzd(int r) { return (((r & 7) ^ ((r >> 1) & 4)) << 1) | ((r >> 3) & 1); }

constexpr int GP_GAL = 0, GP_TOT = 8192;
__device__ __forceinline__ void gla_prep_item(int b, int h, int np, unsigned char* ws, const float* alpha_w, const float* alpha_b, float* DECG, unsigned* cnt, LAS unsigned char* lds, const int w) {
    const int lane = lane_id(), tid = w * 64 + lane;
    bf16_t* GQ = (bf16_t*)(ws + WS_GQ); bf16_t* GK = (bf16_t*)(ws + WS_GK); const float* GA = (const float*)(ws + WS_GA);
    LAS float* GAL = (LAS float*)(lds + GP_GAL); LAS float* TOT = (LAS float*)(lds + GP_TOT);
    const int m0 = b * SEQ + np * 128, d0 = 2 * lane;
#pragma unroll
    for (int c = 0; c < 2; ++c) { const f32x2 v = *(const f32x2*)(GA + (size_t)m0 * 16 + c * 1024 + tid * 2); *(LAS f32x2*)(GAL + c * 1024 + tid * 2) = v; }
    float aw0[16], aw1[16];
#pragma unroll
    for (int r = 0; r < 16; ++r) { const f32x2 a = *(const f32x2*)(alpha_w + r * 512 + h * 128 + d0); aw0[r] = a[0]; aw1[r] = a[1]; }
    const f32x2 ab = *(const f32x2*)(alpha_b + h * 128 + d0);
    unsigned qw[2][8], kw[2][8];
#pragma unroll
    for (int c = 0; c < 2; ++c)
#pragma unroll
        for (int ii = 0; ii < 8; ++ii) { const size_t o = (size_t)(m0 + 64 * c + 8 * w + ii) * 512 + h * 128 + d0; qw[c][ii] = *(const unsigned*)(GQ + o); kw[c][ii] = *(const unsigned*)(GK + o); }
    __syncthreads();
    float bl0[2][8], bl1[2][8];
#pragma unroll
    for (int c = 0; c < 2; ++c) { float run0 = 0.f, run1 = 0.f;
#pragma unroll
        for (int ii = 0; ii < 8; ++ii) { const int i = 64 * c + 8 * w + ii; float x0 = ab[0], x1 = ab[1];
#pragma unroll
            for (int r4 = 0; r4 < 4; ++r4) { const f32x4 gq = *(const LAS f32x4*)(GAL + i * 16 + 4 * r4);
#pragma unroll
                for (int j = 0; j < 4; ++j) { x0 += gq[j] * aw0[4 * r4 + j]; x1 += gq[j] * aw1[4 * r4 + j]; } }
            run0 += logsigmoidf_(x0) * (1.0f / 16.0f); run1 += logsigmoidf_(x1) * (1.0f / 16.0f); bl0[c][ii] = run0; bl1[c][ii] = run1; }
        *(LAS f32x2*)(TOT + c * 1024 + w * 128 + d0) = (f32x2){run0, run1}; }
    __syncthreads();
#pragma unroll
    for (int c = 0; c < 2; ++c) {
        float off0 = 0.f, off1 = 0.f, bt0 = 0.f, bt1 = 0.f;
#pragma unroll
        for (int r = 0; r < 8; ++r) { const f32x2 t = *(const LAS f32x2*)(TOT + c * 1024 + r * 128 + d0); bt0 += t[0]; bt1 += t[1]; if (r < w) { off0 += t[0]; off1 += t[1]; } }
        if (w == 0) *(f32x2*)(DECG + ((size_t)((b * 4 + h) * 32 + 2 * np + c)) * 128 + d0) = (f32x2){__expf(bt0), __expf(bt1)};
#pragma unroll
        for (int ii = 0; ii < 8; ++ii) { const size_t o = (size_t)(m0 + 64 * c + 8 * w + ii) * 512 + h * 128 + d0;
            const float b0 = off0 + bl0[c][ii], b1 = off1 + bl1[c][ii];
            *(unsigned*)(GQ + o) = pk2(bflo(qw[c][ii]) * __expf(b0), bfhi(qw[c][ii]) * __expf(b1));
            *(unsigned*)(GK + o) = pk2(bflo(kw[c][ii]) * __expf(-b0), bfhi(kw[c][ii]) * __expf(-b1)); }
    }
    asm volatile("s_waitcnt vmcnt(0)" ::: "memory");
    __syncthreads();
    if (w == 0 && lane == 0) { __builtin_amdgcn_fence(__ATOMIC_RELEASE, "agent"); asm volatile("s_waitcnt vmcnt(0)" ::: "memory");
        __hip_atomic_fetch_add(cnt + 64 * (b * 4 + h), 2u, __ATOMIC_RELAXED, __HIP_MEMORY_SCOPE_AGENT); }
}

constexpr int GL_BUF = 65536, GL_QI = 0, GL_KI = 16384, GL_VI = 32768, GL_PL = 131072, GL_SS = 131072 + 9216, GL_DEC = 131072 + 9216 + 2048;
template <bool WITHQ> __device__ __forceinline__ void gla_issue_chunk(const unsigned char* ws, int b, int h, int n, LAS unsigned char* buf, int w, int g, int l15) {
    const size_t m0 = (size_t)(b * SEQ + n * 64);
    const unsigned char* qb = ws + WS_GQ + (m0 * 512 + h * 128) * 2;
    const unsigned char* kb = ws + WS_GK + (m0 * 512 + h * 128) * 2;
    const unsigned char* vb = ws + WS_GV + (m0 * 1024 + h * 256) * 2;
#pragma unroll
    for (int jj = 0; jj < 2; ++jj) { const int j = 2 * w + jj; const unsigned off = (unsigned)((4 * j + g) * 1024 + ((l15 ^ ((g << 2) | (j & 3))) << 4));
        if (WITHQ) glds16_asm(qb + off, (unsigned)__builtin_amdgcn_readfirstlane((int)LDS_ADDR(buf + GL_QI + 1024 * j)));
        glds16_asm(kb + off, (unsigned)__builtin_amdgcn_readfirstlane((int)LDS_ADDR(buf + GL_KI + 1024 * j))); }
#pragma unroll
    for (int jj = 0; jj < 4; ++jj) { const int pv = 4 * w + jj, hv = pv >> 4, j = pv & 15; const unsigned off = (unsigned)((4 * j + g) * 2048 + hv * 256 + ((l15 ^ ((g << 2) | (j & 3))) << 4));
        glds16_asm(vb + off, (unsigned)__builtin_amdgcn_readfirstlane((int)LDS_ADDR(buf + GL_VI + 16384 * hv + 1024 * j))); }
}
template <bool FULL> __device__ __forceinline__ void gla_item(int b, int h, int n0, int n1, int init, int seg, unsigned char* ws, const float* gnorm, const float* DECG, float* STATE, unsigned* cnt, unsigned* stflag, unsigned* tmo, LAS unsigned char* lds, const int w) {
    bf16_t* GV = (bf16_t*)(ws + WS_GV); const bf16_t* GR = (const bf16_t*)(ws + WS_GR);
    LAS unsigned char* PL = lds + GL_PL; LAS float* SS = (LAS float*)(lds + GL_SS); LAS float* DEC = (LAS float*)(lds + GL_DEC);
    const float* decg = DECG + (size_t)((b * 4 + h) * 32) * 128;
    if (w == 0) { unsigned sp = 0; const int lane = lane_id();
        while ((unsigned)__builtin_amdgcn_readfirstlane(__hip_atomic_load(cnt + 64 * (b * 4 + h), __ATOMIC_RELAXED, __HIP_MEMORY_SCOPE_AGENT)) < 32u) {
            __builtin_amdgcn_s_sleep(4); if (++sp > (1u << 22)) { if (lane == 0) atomicAdd(tmo, 1u); break; } }
        if (FULL) for (int k = 0; k < (init == 0 ? 1 : 2); ++k) {
            while ((unsigned)__builtin_amdgcn_readfirstlane(__hip_atomic_load(stflag + 64 * ((b * 4 + h) * 2 + k), __ATOMIC_RELAXED, __HIP_MEMORY_SCOPE_AGENT)) == 0u) {
                __builtin_amdgcn_s_sleep(4); if (++sp > (1u << 22)) { if (lane == 0) atomicAdd(tmo, 1u); break; } } }
        __builtin_amdgcn_fence(__ATOMIC_ACQUIRE, "agent"); asm volatile("s_waitcnt vmcnt(0)" ::: "memory"); }
    __syncthreads();
    f32x4 gn[2];
    { const int g = lane_id() >> 4;
#pragma unroll
    for (int et = 0; et < 2; ++et) gn[et] = *(const f32x4*)(gnorm + h * 256 + 32 * w + 16 * et + 4 * g); }
    f32x4 Sacc[8][2];
    float* const st0 = STATE + ((size_t)(((b * 4 + h) * 2 + 0) * 8 + w) * 16) * 256;
    float* const st1 = STATE + ((size_t)(((b * 4 + h) * 2 + 1) * 8 + w) * 16) * 256;
    { const int lane = lane_id(), g = lane >> 4;
#pragma unroll
      for (int dt = 0; dt < 8; ++dt)
#pragma unroll
        for (int et = 0; et < 2; ++et) {
            f32x4 v = (f32x4){0.f, 0.f, 0.f, 0.f};
            if (FULL && init >= 1) v = *(const f32x4*)(st0 + (dt * 2 + et) * 256 + lane * 4);
            Sacc[dt][et] = v; }
      if (FULL && init == 2) {
#pragma unroll
        for (int dt = 0; dt < 8; ++dt) { f32x4 d1 = (f32x4){1.f, 1.f, 1.f, 1.f};
            for (int n = 11; n < 22; ++n) d1 = d1 * *(const f32x4*)(decg + n * 128 + 16 * dt + 4 * g);
#pragma unroll
            for (int et = 0; et < 2; ++et) Sacc[dt][et] = Sacc[dt][et] * d1 + *(const f32x4*)(st1 + (dt * 2 + et) * 256 + lane * 4); } }
      gla_issue_chunk<FULL>(ws, b, h, n0, lds, w, lane >> 4, lane & 15);
      if (w < 2) glds4_asm(decg + n0 * 128 + w * 64 + lane, (unsigned)__builtin_amdgcn_readfirstlane((int)LDS_ADDR(DEC + w * 64))); }
    const int hv = w >> 2;
    u32x2 pend[2][4]; int pend_m0 = -1;
#pragma unroll
    for (int et = 0; et < 2; ++et)
#pragma unroll
        for (int it = 0; it < 4; ++it) pend[et][it] = (u32x2){0u, 0u};
    asm volatile("s_waitcnt vmcnt(0)" ::: "memory");
    for (int n = n0; n < n1; ++n) {
        const int m0 = b * SEQ + n * 64, cur = (n - n0) & 1;
        const int lane = lane_id(), tid = w * 64 + lane, l15 = lane & 15, g = lane >> 4, qq = l15 >> 2, pp = l15 & 3;
        LAS unsigned char* buf = lds + cur * GL_BUF;
        LAS unsigned char* QI = buf + GL_QI; LAS unsigned char* KI = buf + GL_KI; LAS unsigned char* VI = buf + GL_VI + 16384 * hv;
        asm volatile("s_waitcnt vmcnt(0) lgkmcnt(0)" ::: "memory");
        __builtin_amdgcn_s_barrier(); asm volatile("" ::: "memory");
        if constexpr (FULL) { if (pend_m0 >= 0) {
#pragma unroll
            for (int it = 0; it < 4; ++it)
#pragma unroll
                for (int et = 0; et < 2; ++et) *(u32x2*)((unsigned char*)GV + ((size_t)pend_m0 * 1024 + h * 256 + 32 * w) * 2 + (unsigned)((16 * it + l15) * 2048 + (16 * et + 4 * g) * 2)) = pend[et][it]; } }
        if (n + 1 < n1) { gla_issue_chunk<FULL>(ws, b, h, n + 1, lds + (cur ^ 1) * GL_BUF, w, g, l15);
            if (w < 2) glds4_asm(decg + (n + 1) * 128 + w * 64 + lane, (unsigned)__builtin_amdgcn_readfirstlane((int)LDS_ADDR(DEC + (cur ^ 1) * 128 + w * 64))); }
        u32x2 grw[2][4];
        if constexpr (FULL) {
#pragma unroll
        for (int et = 0; et < 2; ++et)
#pragma unroll
            for (int it = 0; it < 4; ++it) grw[et][it] = *(const u32x2*)((const unsigned char*)GR + ((size_t)m0 * 1024 + h * 256 + 32 * w) * 2 + (unsigned)((16 * it + l15) * 2048 + (16 * et + 4 * g) * 2));
#pragma unroll
        for (int tt2 = 0; tt2 < 2; ++tt2) { const int tt = 2 * w + tt2, it = tt >> 2, jt = tt & 3;
            f32x4 pacc = (f32x4){0.f, 0.f, 0.f, 0.f};
            if (jt <= it) { const int rk = 16 * jt + l15, rq = 16 * it + l15; const int xk = swz(rk), xq = swz(rq);
#pragma unroll
                for (int s = 0; s < 4; ++s) { const bf16x8 a = *(const LAS bf16x8*)(KI + 256 * rk + 16 * ((4 * s + g) ^ xk)), bq = *(const LAS bf16x8*)(QI + 256 * rq + 16 * ((4 * s + g) ^ xq));
                    pacc = __builtin_amdgcn_mfma_f32_16x16x32_bf16(a, bq, pacc, 0, 0, 0); }
            }
            const int i = 16 * it + l15; float pv[4];
#pragma unroll
            for (int r = 0; r < 4; ++r) { const int j = 16 * jt + 4 * g + r; pv[r] = (j <= i) ? pacc[r] : 0.f; }
            u32x2 o; o.x = pg8::cvt_pk_bf16(pv[0], pv[1]); o.y = pg8::cvt_pk_bf16(pv[2], pv[3]);
            *(LAS u32x2*)(PL + 144 * i + 2 * (16 * jt + 4 * g)) = o; }
        asm volatile("s_waitcnt lgkmcnt(0)" ::: "memory"); __builtin_amdgcn_s_barrier(); asm volatile("" ::: "memory");
        }
#define GL_TR2(dst, base, ra_, ch_) do { const int ra__ = (ra_), rb__ = ra__ + 4; \
            const v4i16_t x_ = __builtin_amdgcn_ds_read_tr16_b64_v4i16((LAS v4i16_t*)((base) + 256 * ra__ + 16 * ((ch_) ^ swz(ra__)) + 8 * (pp & 1))); \
            const v4i16_t y_ = __builtin_amdgcn_ds_read_tr16_b64_v4i16((LAS v4i16_t*)((base) + 256 * rb__ + 16 * ((ch_) ^ swz(rb__)) + 8 * (pp & 1))); \
            dst = (bf16x8){x_[0], x_[1], x_[2], x_[3], y_[0], y_[1], y_[2], y_[3]}; } while (0)
#define GL_LDQ(dst, s_) do { _Pragma("unroll") for (int it = 0; it < 4; ++it) { const int i = 16 * it + l15, xi = swz(i); \
            const u32x2 lo = *(const LAS u32x2*)(QI + 256 * i + 16 * ((4 * (s_) + (g >> 1)) ^ xi) + 8 * (g & 1)), hi = *(const LAS u32x2*)(QI + 256 * i + 16 * ((4 * (s_) + 2 + (g >> 1)) ^ xi) + 8 * (g & 1)); \
            u32x4 t; t.x = lo.x; t.y = lo.y; t.z = hi.x; t.w = hi.y; dst[it] = __builtin_bit_cast(bf16x8, t); } } while (0)
#define GL_SQ(src, s_) do { _Pragma("unroll") for (int et = 0; et < 2; ++et) { u32x4 t; const f32x4 s0 = Sacc[2 * (s_)][et], s1 = Sacc[2 * (s_) + 1][et]; \
            t.x = pg8::cvt_pk_bf16(s0[0], s0[1]); t.y = pg8::cvt_pk_bf16(s0[2], s0[3]); t.z = pg8::cvt_pk_bf16(s1[0], s1[1]); t.w = pg8::cvt_pk_bf16(s1[2], s1[3]); \
            const bf16x8 sf = __builtin_bit_cast(bf16x8, t); \
            _Pragma("unroll") for (int it = 0; it < 4; ++it) oacc[et][it] = __builtin_amdgcn_mfma_f32_16x16x32_bf16(sf, src[it], oacc[et][it], 0, 0, 0); } } while (0)
        bf16x8 vf[2][2];
#pragma unroll
        for (int et = 0; et < 2; ++et)
#pragma unroll
            for (int s = 0; s < 2; ++s) GL_TR2(vf[et][s], VI, 32 * s + 8 * g + qq, 2 * (2 * (w & 3) + et) + (pp >> 1));
        f32x4 oacc[2][4];
#pragma unroll
        for (int et = 0; et < 2; ++et)
#pragma unroll
            for (int it = 0; it < 4; ++it) oacc[et][it] = (f32x4){0.f, 0.f, 0.f, 0.f};
#define GL_SU(src, s_, d0_) do { _Pragma("unroll") for (int dt = 0; dt < 4; ++dt) _Pragma("unroll") for (int et = 0; et < 2; ++et) \
                Sacc[(d0_) + dt][et] = __builtin_amdgcn_mfma_f32_16x16x32_bf16(src[dt], vf[et][s_], Sacc[(d0_) + dt][et], 0, 0, 0); } while (0)
        {
            bf16x8 ka[4], kb[4];
            if constexpr (FULL) {
                bf16x8 qa[4], qb[4];
                GL_LDQ(qa, 0); GL_LDQ(qb, 1);
                GL_SQ(qa, 0); GL_LDQ(qa, 2);
                GL_SQ(qb, 1); GL_LDQ(qb, 3);
                bf16x8 pf0[4], pf1[4];
#pragma unroll
                for (int it = 0; it < 4; ++it) pf0[it] = *(const LAS bf16x8*)(PL + 144 * (16 * it + l15) + 16 * g);
                GL_SQ(qa, 2);
#pragma unroll
                for (int it = 0; it < 4; ++it) pf1[it] = *(const LAS bf16x8*)(PL + 144 * (16 * it + l15) + 64 + 16 * g);
                GL_SQ(qb, 3);
#pragma unroll
                for (int dt = 0; dt < 4; ++dt) GL_TR2(ka[dt], KI, 8 * g + qq, 2 * dt + (pp >> 1));
#pragma unroll
                for (int et = 0; et < 2; ++et)
#pragma unroll
                    for (int it = 0; it < 4; ++it) oacc[et][it] = __builtin_amdgcn_mfma_f32_16x16x32_bf16(vf[et][0], pf0[it], oacc[et][it], 0, 0, 0);
#pragma unroll
                for (int dt = 0; dt < 4; ++dt) GL_TR2(kb[dt], KI, 8 * g + qq, 2 * (dt + 4) + (pp >> 1));
#pragma unroll
                for (int et = 0; et < 2; ++et)
#pragma unroll
                    for (int it = 0; it < 4; ++it) oacc[et][it] = __builtin_amdgcn_mfma_f32_16x16x32_bf16(vf[et][1], pf1[it], oacc[et][it], 0, 0, 0);
            } else {
#pragma unroll
                for (int dt = 0; dt < 4; ++dt) GL_TR2(ka[dt], KI, 8 * g + qq, 2 * dt + (pp >> 1));
#pragma unroll
                for (int dt = 0; dt < 4; ++dt) GL_TR2(kb[dt], KI, 8 * g + qq, 2 * (dt + 4) + (pp >> 1));
            }
            GL_SU(ka, 0, 0);
#pragma unroll
            for (int dt = 0; dt < 4; ++dt) GL_TR2(ka[dt], KI, 32 + 8 * g + qq, 2 * dt + (pp >> 1));
            GL_SU(kb, 0, 4);
#pragma unroll
            for (int dt = 0; dt < 4; ++dt) GL_TR2(kb[dt], KI, 32 + 8 * g + qq, 2 * (dt + 4) + (pp >> 1));
            GL_SU(ka, 1, 0);
            GL_SU(kb, 1, 4);
        }
#undef GL_TR2
#undef GL_LDQ
#undef GL_SQ
#undef GL_SU
#pragma unroll
        for (int dt = 0; dt < 8; ++dt) { const f32x4 d4 = *(const LAS f32x4*)(DEC + cur * 128 + 16 * dt + 4 * g);
#pragma unroll
            for (int et = 0; et < 2; ++et) Sacc[dt][et] = Sacc[dt][et] * d4; }
        if constexpr (FULL) {
        {
            float ssq[4];
#pragma unroll
            for (int it = 0; it < 4; ++it) { float s = 0.f;
#pragma unroll
                for (int et = 0; et < 2; ++et) { const f32x4 o = oacc[et][it]; s += (o[0] * o[0] + o[1] * o[1]) + (o[2] * o[2] + o[3] * o[3]); }
                s = rows4_sum(s); ssq[it] = s; }
            if (g == 0) {
#pragma unroll
                for (int it = 0; it < 4; ++it) SS[w * 64 + 16 * it + l15] = ssq[it]; }
        }
        asm volatile("s_waitcnt lgkmcnt(0)" ::: "memory"); __builtin_amdgcn_s_barrier(); asm volatile("" ::: "memory");
#pragma unroll
        for (int it = 0; it < 4; ++it) { const int i = 16 * it + l15; float tot = 0.f;
#pragma unroll
            for (int ww = 0; ww < 8; ++ww) tot += SS[ww * 64 + i];
            const float rstd = __builtin_amdgcn_rsqf(tot * (1.0f / 256.0f) + EPS);
#pragma unroll
            for (int et = 0; et < 2; ++et) {
                const u32x2 gw = grw[et][it];
                const f32x4 o = oacc[et][it];
                const float v0 = o[0] * rstd * gn[et][0] * siluf_(bflo(gw.x)), v1 = o[1] * rstd * gn[et][1] * siluf_(bfhi(gw.x));
                const float v2 = o[2] * rstd * gn[et][2] * siluf_(bflo(gw.y)), v3 = o[3] * rstd * gn[et][3] * siluf_(bfhi(gw.y));
                u32x2 ow; ow.x = pg8::cvt_pk_bf16(v0, v1); ow.y = pg8::cvt_pk_bf16(v2, v3);
                pend[et][it] = ow; }
        }
        pend_m0 = m0;
        }
    }
    if constexpr (FULL) { if (pend_m0 >= 0) { const int lane = lane_id(), l15 = lane & 15, g = lane >> 4;
#pragma unroll
        for (int it = 0; it < 4; ++it)
#pragma unroll
            for (int et = 0; et < 2; ++et) *(u32x2*)((unsigned char*)GV + ((size_t)pend_m0 * 1024 + h * 256 + 32 * w) * 2 + (unsigned)((16 * it + l15) * 2048 + (16 * et + 4 * g) * 2)) = pend[et][it]; } }
    if constexpr (!FULL) {
        const int lane = lane_id();
        float* const so = seg ? st1 : st0;
#pragma unroll
        for (int dt = 0; dt < 8; ++dt)
#pragma unroll
            for (int et = 0; et < 2; ++et) *(f32x4*)(so + (dt * 2 + et) * 256 + lane * 4) = Sacc[dt][et];
        asm volatile("s_waitcnt vmcnt(0)" ::: "memory");
        __syncthreads();
        if (w == 0 && lane == 0) { __builtin_amdgcn_fence(__ATOMIC_RELEASE, "agent"); asm volatile("s_waitcnt vmcnt(0)" ::: "memory");
            __hip_atomic_store(stflag + 64 * ((b * 4 + h) * 2 + seg), 1u, __ATOMIC_RELAXED, __HIP_MEMORY_SCOPE_AGENT); }
    }
    asm volatile("s_waitcnt vmcnt(0) lgkmcnt(0)" ::: "memory");
    __syncthreads();
}

template <int V> struct IConst { static constexpr int value = V; };
constexpr int DS_SC = 0, DS_SEL = 131072, DS_CNT = 131072 + 8192, DS_RB = 143360;
__device__ __forceinline__ int t5_bucket(int d) {
    if (d < 16) return d;
    const int large = 16 + (int)(__logf((float)d * (1.0f / 16.0f)) * (16.0f / 2.0794415416798357f));
    return large < 31 ? large : 31;
}
__device__ __forceinline__ void dsa_item(int b, int qt, unsigned char* ws, const float* rel_bias, LAS unsigned char* lds, const int w) {
    const int lane = lane_id(), tid = w * 64 + lane, l15 = lane & 15, g = lane >> 4;
    const bf16_t* IQ = (const bf16_t*)(ws + WS_IQ); const bf16_t* IK = (const bf16_t*)(ws + WS_IK); const float* IW = (const float*)(ws + WS_IW);
    const bf16_t* CKV = (const bf16_t*)(ws + WS_CKV); bf16_t* DQ = (bf16_t*)(ws + WS_DQ);
    LAS float* SC = (LAS float*)(lds + DS_SC); LAS unsigned short* SEL = (LAS unsigned short*)(lds + DS_SEL); LAS int* CNT = (LAS int*)(lds + DS_CNT);
    const int mb = b * SEQ, t0 = 16 * qt;
    {
        bf16x8 af[8][2];
#pragma unroll
        for (int hh = 0; hh < 8; ++hh)
#pragma unroll
            for (int ks = 0; ks < 2; ++ks) af[hh][ks] = *(const bf16x8*)(IQ + (size_t)(mb + t0 + l15) * 512 + hh * 64 + 32 * ks + 8 * g);
        float wg[4][8];
#pragma unroll
        for (int r = 0; r < 4; ++r) { const f32x4 a = *(const f32x4*)(IW + (size_t)(mb + t0 + 4 * g + r) * 8), c = *(const f32x4*)(IW + (size_t)(mb + t0 + 4 * g + r) * 8 + 4);
#pragma unroll
            for (int j = 0; j < 4; ++j) { wg[r][j] = a[j] * 0.04419417382415922f; wg[r][4 + j] = c[j] * 0.04419417382415922f; } }
        const bf16_t* ikp = IK + (size_t)(mb + l15) * 64 + 8 * g;
#define DS_LDK(d0, d1, kt_) do { if ((kt_) <= qt) { d0 = *(const bf16x8*)(ikp + (size_t)(16 * (kt_)) * 64); d1 = *(const bf16x8*)(ikp + (size_t)(16 * (kt_)) * 64 + 32); } } while (0)
#define DS_TILE(b0, b1, kt_) do { if ((kt_) <= qt) { float sc[4] = {0.f, 0.f, 0.f, 0.f}; \
            _Pragma("unroll") for (int hh = 0; hh < 8; ++hh) { f32x4 a = (f32x4){0.f, 0.f, 0.f, 0.f}; \
                a = __builtin_amdgcn_mfma_f32_16x16x32_bf16(af[hh][0], b0, a, 0, 0, 0); a = __builtin_amdgcn_mfma_f32_16x16x32_bf16(af[hh][1], b1, a, 0, 0, 0); \
                _Pragma("unroll") for (int r = 0; r < 4; ++r) { const float af_ = a[r]; const int ab_ = __float_as_int(af_); sc[r] += wg[r][hh] * __int_as_float(ab_ > 0 ? ab_ : 0); } } \
            _Pragma("unroll") for (int r = 0; r < 4; ++r) SC[(4 * g + r) * 2048 + 16 * (kt_) + l15] = sc[r]; } } while (0)
        bf16x8 ka0 = (bf16x8){0, 0, 0, 0, 0, 0, 0, 0}, ka1 = ka0, kb0 = ka0, kb1 = ka0, kc0 = ka0, kc1 = ka0;
        DS_LDK(ka0, ka1, w); DS_LDK(kb0, kb1, w + 8); DS_LDK(kc0, kc1, w + 16);
        for (int kt = w; kt <= qt; kt += 24) {
            { const bf16x8 x0 = ka0, x1 = ka1; DS_LDK(ka0, ka1, kt + 24); DS_TILE(x0, x1, kt); }
            { const bf16x8 x0 = kb0, x1 = kb1; DS_LDK(kb0, kb1, kt + 32); DS_TILE(x0, x1, kt + 8); }
            { const bf16x8 x0 = kc0, x1 = kc1; DS_LDK(kc0, kc1, kt + 40); DS_TILE(x0, x1, kt + 16); }
        }
#undef DS_LDK
#undef DS_TILE
    }
    __syncthreads();
    for (int ph = 0; ph < 4; ++ph) {
      const int isS3 = (w < 4) ? (ph & 1) : (ph >> 1);
      const int q2 = (w < 4) ? (ph >> 1) : (ph & 1);
      if (!isS3) {
            const int tt = 2 * w + q2, t = t0 + tt, n = t + 1;
            LAS unsigned short* sel = SEL + tt * 256;
            if (n <= 256) {
                for (int k = lane; k < 256; k += 64) sel[k] = (unsigned short)(k < n ? k : 0);
                if (lane == 0) CNT[tt] = n;
            } else {
                const int nb8 = (n + 255) >> 8;
                float val[32];
#pragma unroll
                for (int i = 0; i < 32; ++i) val[i] = SC[tt * 2048 + lane + 64 * i];
#pragma unroll
                for (int i = 0; i < 32; ++i) val[i] = (lane + 64 * i < n) ? val[i] : -__builtin_inff();
                float lo = 0.f, hi = 0.f, piv = 0.f; bool found = false; int tie_need = 0;
                { int g0 = 0, g1 = 0, g2 = 0, g3 = 0;
#pragma unroll
                  for (int i8 = 0; i8 < 8; ++i8) if (i8 < nb8) { g0 += (val[4 * i8] > 0.f) ? 1 : 0; g1 += (val[4 * i8 + 1] > 0.f) ? 1 : 0; g2 += (val[4 * i8 + 2] > 0.f) ? 1 : 0; g3 += (val[4 * i8 + 3] > 0.f) ? 1 : 0; }
                  const int cgt0 = wave_isum((g0 + g1) + (g2 + g3));
                  if (cgt0 == 256) { found = true; }
                  else if (cgt0 > 256) {
                      int m0 = 0, m1 = 0;
#pragma unroll
                      for (int i = 0; i < 32; i += 4) { m0 = max(max(m0, __float_as_int(val[i])), __float_as_int(val[i + 1])); m1 = max(max(m1, __float_as_int(val[i + 2])), __float_as_int(val[i + 3])); }
                      hi = __int_as_float(wave_imax(max(m0, m1)));
                  } else {
                      int e0 = 0, e1 = 0, e2 = 0, e3 = 0;
#pragma unroll
                      for (int i8 = 0; i8 < 8; ++i8) if (i8 < nb8) { e0 += (val[4 * i8] >= 0.f) ? 1 : 0; e1 += (val[4 * i8 + 1] >= 0.f) ? 1 : 0; e2 += (val[4 * i8 + 2] >= 0.f) ? 1 : 0; e3 += (val[4 * i8 + 3] >= 0.f) ? 1 : 0; }
                      const int cge0 = wave_isum((e0 + e1) + (e2 + e3));
                      if (cge0 >= 256) { found = true; tie_need = 256 - cgt0; }
                      else {
                          unsigned m0 = 0u, m1 = 0u;
#pragma unroll
                          for (int i = 0; i < 32; i += 2) { m0 = max(m0, (lane + 64 * i < n) ? __float_as_uint(val[i]) : 0u); m1 = max(m1, (lane + 64 * (i + 1) < n) ? __float_as_uint(val[i + 1]) : 0u); }
                          lo = __uint_as_float(wave_umax(max(m0, m1)));
                      }
                  } }
                auto bisect = [&](auto NBC) __attribute__((always_inline)) {
                    constexpr int NB = decltype(NBC)::value;
                    for (int itn = 0; itn < 40 && !found; ++itn) {
                        const float mid = 0.5f * lo + 0.5f * hi;
                        if (!(mid > lo) || !(mid < hi)) break;
                        int lc0 = 0, lc1 = 0, lc2 = 0, lc3 = 0;
#pragma unroll
                        for (int i8 = 0; i8 < NB; ++i8) { lc0 += (val[4 * i8] > mid) ? 1 : 0; lc1 += (val[4 * i8 + 1] > mid) ? 1 : 0; lc2 += (val[4 * i8 + 2] > mid) ? 1 : 0; lc3 += (val[4 * i8 + 3] > mid) ? 1 : 0; }
                        const int cnt = wave_isum((lc0 + lc1) + (lc2 + lc3));
                        if (cnt == 256) { piv = mid; found = true; break; }
                        if (cnt > 256) lo = mid; else hi = mid;
                    } };
                switch (nb8) { case 2: bisect(IConst<2>{}); break; case 3: bisect(IConst<3>{}); break; case 4: bisect(IConst<4>{}); break; case 5: bisect(IConst<5>{}); break;
                               case 6: bisect(IConst<6>{}); break; case 7: bisect(IConst<7>{}); break; default: bisect(IConst<8>{}); break; }
                if (found && tie_need > 0) {
                    const unsigned long long lt = (1ull << lane) - 1ull;
                    int pos = 0, eqs = 0;
#pragma unroll
                    for (int i8 = 0; i8 < 8; ++i8) if (i8 < nb8) {
#pragma unroll
                        for (int i = 0; i < 4; ++i) {
                            const float kv = val[4 * i8 + i];
                            const bool gt = kv > 0.f, eq = kv == 0.f;
                            const unsigned long long meq = __ballot(eq);
                            const bool take = gt || (eq && (eqs + __builtin_popcountll(meq & lt)) < tie_need);
                            const unsigned long long mt = __ballot(take);
                            if (take) sel[pos + __builtin_popcountll(mt & lt)] = (unsigned short)(lane + 64 * (4 * i8 + i));
                            pos += __builtin_popcountll(mt); eqs += __builtin_popcountll(meq);
                        } }
                } else
                if (found) {
                    int pos = 0;
                    LAS unsigned short* const dummy = (LAS unsigned short*)(lds + DS_CNT + 64) + lane;
#pragma unroll
                    for (int i = 0; i < 32; ++i) {
                        const bool take = val[i] > piv;
                        const unsigned long long m = __ballot(take);
                        const int p = pos + (int)__builtin_amdgcn_mbcnt_hi((unsigned)(m >> 32), __builtin_amdgcn_mbcnt_lo((unsigned)m, 0u));
                        LAS unsigned short* const dst = take ? (sel + p) : dummy;
                        *dst = (unsigned short)(lane + 64 * i);
                        pos += __builtin_popcountll(m);
                    }
                } else {
                unsigned key[32];
#pragma unroll
                for (int i = 0; i < 32; ++i) { const unsigned u = __builtin_bit_cast(unsigned, val[i]); key[i] = (u & 0x80000000u) ? ~u : (u | 0x80000000u); }
                unsigned T = 0u;
                for (int bit = 31; bit >= 0; --bit) {
                    const unsigned cand = T | (1u << bit); int lc = 0;
#pragma unroll
                    for (int i8 = 0; i8 < 8; ++i8) if (i8 < nb8) {
#pragma unroll
                        for (int i = 0; i < 4; ++i) lc += (key[4 * i8 + i] >= cand) ? 1 : 0; }
                    const int cnt = wave_isum(lc);
                    if (cnt >= 256) { T = cand; if (cnt == 256) break; }
                }
                int lg_ = 0;
#pragma unroll
                for (int i8 = 0; i8 < 8; ++i8) if (i8 < nb8) {
#pragma unroll
                    for (int i = 0; i < 4; ++i) lg_ += (key[4 * i8 + i] > T) ? 1 : 0; }
                const int cgt = wave_isum(lg_);
                const int need = 256 - cgt;
                const unsigned long long lt = (1ull << lane) - 1ull;
                int pos = 0, eqs = 0;
#pragma unroll
                for (int i8 = 0; i8 < 8; ++i8) if (i8 < nb8) {
#pragma unroll
                    for (int i = 0; i < 4; ++i) {
                        const unsigned kv = key[4 * i8 + i];
                        const bool gt = kv > T, eq = kv == T;
                        const unsigned long long meq = __ballot(eq);
                        const bool take = gt || (eq && (eqs + __builtin_popcountll(meq & lt)) < need);
                        const unsigned long long mt = __ballot(take);
                        if (take) sel[pos + __builtin_popcountll(mt & lt)] = (unsigned short)(lane + 64 * (4 * i8 + i));
                        pos += __builtin_popcountll(mt); eqs += __builtin_popcountll(meq);
                    } }
                }
                if (lane == 0) CNT[tt] = 256;
            }
      } else {
        asm volatile("s_waitcnt lgkmcnt(0)" ::: "memory");
        LAS unsigned char* KT = lds + DS_SC + w * 16384;
        const LAS float* RB = (const LAS float*)(lds + DS_RB);
        const int qq = l15 >> 2, pp = l15 & 3;
        const int tt = 2 * w + q2, t = t0 + tt, m = mb + t;
        const int cnt = CNT[tt], nt = (cnt + 31) >> 5;
        const LAS unsigned short* sel = SEL + tt * 256;
        bf16x8 qf[4];
#pragma unroll
        for (int ks = 0; ks < 4; ++ks) { qf[ks] = (bf16x8){0, 0, 0, 0, 0, 0, 0, 0}; if (l15 < 8) qf[ks] = *(const bf16x8*)(DQ + (size_t)m * 1024 + l15 * 128 + 32 * ks + 8 * g); }
        f32x4 oacc[8];
#pragma unroll
        for (int ct = 0; ct < 8; ++ct) oacc[ct] = (f32x4){0.f, 0.f, 0.f, 0.f};
        float mrun = -__builtin_inff(), lrun = 0.f;
        __builtin_amdgcn_s_waitcnt(0x0F70);
        unsigned lx[8];
#pragma unroll
        for (int j = 0; j < 8; ++j) lx[j] = (unsigned)((l15 ^ swzd(j + 8 * g)) << 4);
        const char* ckb = (const char*)CKV + ((size_t)mb << 8);
        const unsigned kt0a = (unsigned)__builtin_amdgcn_readfirstlane((int)LDS_ADDR(KT));
#define DS_GATHER_W(sw_) do { \
            glds16x8_asm(ckb, ((sw_.x & 0xffffu) << 8) + lx[0], ((sw_.x >> 16) << 8) + lx[1], ((sw_.y & 0xffffu) << 8) + lx[2], ((sw_.y >> 16) << 8) + lx[3], \
                              ((sw_.z & 0xffffu) << 8) + lx[4], ((sw_.z >> 16) << 8) + lx[5], ((sw_.w & 0xffffu) << 8) + lx[6], ((sw_.w >> 16) << 8) + lx[7], \
                         kt0a, kt0a + 1024u, kt0a + 2048u, kt0a + 3072u, kt0a + 4096u, kt0a + 5120u, kt0a + 6144u, kt0a + 7168u); } while (0)
#define DS_BIAS_ADDR(dst_, lt_) do { const int so_ = 32 * (lt_) + 4 * g; \
            const u32x2 s0_ = *(const LAS u32x2*)(sel + so_), s1_ = *(const LAS u32x2*)(sel + so_ + 16); \
            const int s8_[8] = {(int)(s0_.x & 0xffffu), (int)(s0_.x >> 16), (int)(s0_.y & 0xffffu), (int)(s0_.y >> 16), (int)(s1_.x & 0xffffu), (int)(s1_.x >> 16), (int)(s1_.y & 0xffffu), (int)(s1_.y >> 16)}; \
            _Pragma("unroll") for (int e = 0; e < 8; ++e) { int dist = t - s8_[e]; dist = dist > 128 ? 128 : dist; dst_[e] = dist * 32 + rbo; } } while (0)
        const int rbo = (l15 & 7) * 4;
        { const u32x4 swg0 = *(const LAS u32x4*)(sel + 8 * g); DS_GATHER_W(swg0); }
        float bnext[8];
        { int ba_[8]; DS_BIAS_ADDR(ba_, 0);
#pragma unroll
          for (int e = 0; e < 8; ++e) bnext[e] = *(const LAS float*)((const LAS unsigned char*)RB + ba_[e]); }
        const int ra_ = 4 * g + qq, rb_ = ra_ + 16;
        const int xa_ = swzd(ra_), xb_ = swzd(rb_), rhoa_ = 4 * (ra_ & 7) + (ra_ >> 3), rhob_ = 4 * (rb_ & 7) + (rb_ >> 3);
        const int xr_ = swzd(l15), rho_ = 4 * (l15 & 7) + (l15 >> 3);
        for (int lt = 0; lt < nt; ++lt) {
            float bcur[8];
#pragma unroll
            for (int e = 0; e < 8; ++e) bcur[e] = bnext[e];
            asm volatile("s_waitcnt vmcnt(0)" ::: "memory");
            __builtin_amdgcn_sched_barrier(0);
            bf16x8 vfr[8], kfr[2][4];
#pragma unroll
            for (int ct = 0; ct < 8; ++ct) { const int ch = 2 * ct + (pp >> 1);
                const v4i16_t va = __builtin_amdgcn_ds_read_tr16_b64_v4i16((LAS v4i16_t*)(KT + 256 * rhoa_ + 16 * (ch ^ xa_) + 8 * (pp & 1)));
                const v4i16_t vb = __builtin_amdgcn_ds_read_tr16_b64_v4i16((LAS v4i16_t*)(KT + 256 * rhob_ + 16 * (ch ^ xb_) + 8 * (pp & 1)));
                vfr[ct] = (bf16x8){va[0], va[1], va[2], va[3], vb[0], vb[1], vb[2], vb[3]}; }
#pragma unroll
            for (int kt = 0; kt < 2; ++kt)
#pragma unroll
                for (int ks = 0; ks < 4; ++ks) kfr[kt][ks] = *(const LAS bf16x8*)(KT + 512 * kt + 256 * rho_ + 16 * ((4 * ks + g) ^ xr_));
            const int ltn = lt + 1 < nt ? lt + 1 : lt;
            const u32x4 swg = *(const LAS u32x4*)(sel + 32 * ltn + 8 * g);
            int ba[8]; DS_BIAS_ADDR(ba, ltn);
            asm volatile("s_waitcnt lgkmcnt(0)" ::: "memory");
            __builtin_amdgcn_sched_barrier(0);
            if (lt + 1 < nt) DS_GATHER_W(swg);
#pragma unroll
            for (int e = 0; e < 8; ++e) bnext[e] = *(const LAS float*)((const LAS unsigned char*)RB + ba[e]);
            __builtin_amdgcn_sched_barrier(0);
            float lg[2][4];
#pragma unroll
            for (int kt = 0; kt < 2; ++kt) {
                f32x4 a0 = (f32x4){0.f, 0.f, 0.f, 0.f}, a1 = a0;
                a0 = __builtin_amdgcn_mfma_f32_16x16x32_bf16(kfr[kt][0], qf[0], a0, 0, 0, 0); a1 = __builtin_amdgcn_mfma_f32_16x16x32_bf16(kfr[kt][2], qf[2], a1, 0, 0, 0);
                a0 = __builtin_amdgcn_mfma_f32_16x16x32_bf16(kfr[kt][1], qf[1], a0, 0, 0, 0); a1 = __builtin_amdgcn_mfma_f32_16x16x32_bf16(kfr[kt][3], qf[3], a1, 0, 0, 0);
#pragma unroll
                for (int rr = 0; rr < 4; ++rr) lg[kt][rr] = (a0[rr] + a1[rr]) * (0.08838834764831845f * 1.4426950408889634f) + bcur[4 * kt + rr];
            }
            if (cnt - 32 * lt < 32) {
#pragma unroll
                for (int kt = 0; kt < 2; ++kt)
#pragma unroll
                    for (int rr = 0; rr < 4; ++rr) lg[kt][rr] = (32 * lt + 16 * kt + 4 * g + rr < cnt) ? lg[kt][rr] : -__builtin_inff();
            }
            float tmax;
            { float m1_, m2_; asm("v_max3_f32 %0, %1, %2, %3" : "=v"(m1_) : "v"(lg[0][0]), "v"(lg[0][1]), "v"(lg[0][2]));
              asm("v_max3_f32 %0, %1, %2, %3" : "=v"(m2_) : "v"(lg[0][3]), "v"(lg[1][0]), "v"(lg[1][1]));
              asm("v_max3_f32 %0, %1, %2, %3" : "=v"(m1_) : "v"(m1_), "v"(lg[1][2]), "v"(lg[1][3]));
              asm("v_max_f32 %0, %1, %2" : "=v"(tmax) : "v"(m1_), "v"(m2_)); }
            tmax = rows4_max_fast(tmax);
            if (__any(tmax > mrun + 8.0f)) {
                const float mnew = fmaxf(mrun, tmax), alpha = __builtin_amdgcn_exp2f(mrun - mnew);
                lrun *= alpha; mrun = mnew;
#pragma unroll
                for (int ct = 0; ct < 8; ++ct) oacc[ct] = oacc[ct] * alpha;
            }
            float psum = 0.f;
#pragma unroll
            for (int kt = 0; kt < 2; ++kt)
#pragma unroll
                for (int rr = 0; rr < 4; ++rr) { lg[kt][rr] = __builtin_amdgcn_exp2f(lg[kt][rr] - mrun); psum += lg[kt][rr]; }
            lrun += psum;
            {
                u32x4 pw; pw.x = pg8::cvt_pk_bf16(lg[0][0], lg[0][1]); pw.y = pg8::cvt_pk_bf16(lg[0][2], lg[0][3]);
                pw.z = pg8::cvt_pk_bf16(lg[1][0], lg[1][1]); pw.w = pg8::cvt_pk_bf16(lg[1][2], lg[1][3]);
                const bf16x8 pf = __builtin_bit_cast(bf16x8, pw);
#pragma unroll
                for (int ct = 0; ct < 8; ++ct) oacc[ct] = __builtin_amdgcn_mfma_f32_16x16x32_bf16(vfr[ct], pf, oacc[ct], 0, 0, 0);
            }
            asm volatile("s_waitcnt lgkmcnt(0)" ::: "memory");
            __builtin_amdgcn_sched_barrier(0);
        }
#undef DS_GATHER_W
#undef DS_BIAS_ADDR
        lrun = rows4_sum(lrun);
        const float inv = __builtin_amdgcn_rcpf(lrun);
        if (l15 < 8) {
#pragma unroll
            for (int ct = 0; ct < 8; ++ct) { u32x2 ow; ow.x = pg8::cvt_pk_bf16(oacc[ct][0] * inv, oacc[ct][1] * inv); ow.y = pg8::cvt_pk_bf16(oacc[ct][2] * inv, oacc[ct][3] * inv);
                *(u32x2*)(DQ + (size_t)m * 1024 + l15 * 128 + 16 * ct + 4 * g) = ow; }
        }
        asm volatile("s_waitcnt vmcnt(0)" ::: "memory");
      }
    }
    __syncthreads();
}

#define XB_TMO      128
#define XB_XCNT(j)  (256  + 64 * (j))
#define XB_XSUB(j)  (1280 + 64 * (j))
#define XB_XGEN(j)  (2304 + 64 * (j))
#define XB_TOP      3328
#define XB_TOPGEN   3392
#define XCD_BAR_WORDS 3456
#define XB_SPIN_CAP (1u << 20)
__device__ __forceinline__ unsigned xb_ld(unsigned* p)              { return __hip_atomic_load(p, __ATOMIC_RELAXED, __HIP_MEMORY_SCOPE_AGENT); }
__device__ __forceinline__ unsigned xb_add(unsigned* p, unsigned v) { return __hip_atomic_fetch_add(p, v, __ATOMIC_RELAXED, __HIP_MEMORY_SCOPE_AGENT); }
__device__ __forceinline__ unsigned xb_xcc_id() { return (unsigned)__builtin_amdgcn_s_getreg((3 << 11) | 20) & 0xFu; }
#define XB_SPIN(cond, bar) do { unsigned _sp = 0; while (cond) { __builtin_amdgcn_s_sleep(1); \
    if ((++_sp & 255u) == 0u) { if (xb_ld(&(bar)[XB_TMO])) break; if (_sp > XB_SPIN_CAP) { atomicAdd(&(bar)[XB_TMO], 1u); break; } } } } while (0)
__device__ __forceinline__ void xcd_barrier_complete(unsigned* bar, unsigned x, unsigned G, unsigned& nloc, unsigned& nx) {
    unsigned sum, cnt, mine, sp = 0u;
    for (;;) {
        sum = 0u; cnt = 0u; mine = 0u;
#pragma unroll
        for (unsigned j = 0; j < 16; ++j) { const unsigned c = xb_ld(&bar[XB_XCNT(j)]); sum += c; cnt += (c > 0u) ? 1u : 0u; mine = (j == x) ? c : mine; }
        if (sum == G) break;
        __builtin_amdgcn_s_sleep(1);
        if ((++sp & 255u) == 0u) { if (xb_ld(&bar[XB_TMO])) break; if (sp > XB_SPIN_CAP) { atomicAdd(&bar[XB_TMO], 1u); break; } }
    }
    nloc = mine > 0u ? mine : 1u; nx = cnt > 0u ? cnt : 1u;
}
__device__ __forceinline__ void xcd_barrier_arrive(unsigned* bar, volatile LAS unsigned* st, bool leader, unsigned G) {
    asm volatile("s_waitcnt vmcnt(0)" ::: "memory");
    __syncthreads();
    if (leader) {
        __builtin_amdgcn_s_waitcnt(0);
        const unsigned x = xb_xcc_id();
        unsigned nloc = st[0], nx = st[1];
        if (nloc == 0u) { xcd_barrier_complete(bar, x, G, nloc, nx); st[0] = nloc; st[1] = nx; }
        const unsigned old = xb_add(&bar[XB_XSUB(x)], 1u);
        const unsigned gen = old / nloc;
        st[2] = gen;
        if (old + 1u == (gen + 1u) * nloc) {
            __builtin_amdgcn_fence(__ATOMIC_RELEASE, "agent");
            asm volatile("s_waitcnt vmcnt(0)" ::: "memory");
            const unsigned og = xb_add(&bar[XB_TOP], 1u);
            const unsigned tg = og / nx;
            if (og + 1u == (tg + 1u) * nx) {
#pragma unroll
                for (unsigned j = 0; j < 16; ++j) (void)xb_add(&bar[XB_XGEN(j)], 1u);
            }
        }
    }
}
template <bool INLOOP> __device__ __forceinline__ void xcd_barrier_wait(unsigned* bar, volatile LAS unsigned* st, bool leader) {
    if (leader) {
        const unsigned gen = st[2];
        const unsigned x = xb_xcc_id();
        XB_SPIN(xb_ld(&bar[XB_XGEN(x)]) == gen, bar);
        __builtin_amdgcn_fence(__ATOMIC_ACQUIRE, "agent");
        asm volatile("s_waitcnt vmcnt(0)" ::: "memory");
    }
    if constexpr (INLOOP) __builtin_amdgcn_s_barrier(); else __syncthreads();
}
__device__ __forceinline__ void xcd_barrier(unsigned* bar, volatile LAS unsigned* st, bool leader, unsigned G) {
    xcd_barrier_arrive(bar, st, leader, G);
    xcd_barrier_wait<false>(bar, st, leader);
}
struct BarHook { static constexpr bool KROT = true; unsigned* bar; volatile LAS unsigned* st; int wave;
    __device__ __forceinline__ int rot(const pg8::Unit& u) const { return 4 * u.pn; }
    __device__ __forceinline__ void wait() const { xcd_barrier_wait<true>(bar, st, wave == 0 && lane_id() == 0); } };

struct Args { const float* in[22]; float* out; unsigned char* ws; int ph_lo, ph_hi; };

__global__ void __launch_bounds__(512, 2) fwd_kernel(Args args) {
    extern __shared__ __attribute__((aligned(16))) unsigned char lds_raw[];
    LAS unsigned char* lds = (LAS unsigned char*)lds_raw;
    const int wave = __builtin_amdgcn_readfirstlane(threadIdx.x >> 6);
    const int G = gridDim.x, bid = blockIdx.x;
    unsigned char* ws = args.ws;
    unsigned* ctl = (unsigned*)(ws + WS_CTL);
    const float* x = args.in[0]; const float* p = args.in[1];
    float* out = args.out;
    const int lo = args.ph_lo, hi = args.ph_hi;
#define IN(k) (lo <= (k) && (k) < hi)
#if MK_N_LAUNCHES == 1
    unsigned* const gbar = ctl + CW_BAR;
    volatile LAS unsigned* const bst = (volatile LAS unsigned*)(lds + LDS_MISC + 32);
    { const bool ldr = (wave == 0 && lane_id() == 0);
      if (ldr) { bst[0] = 0u; bst[1] = 0u; (void)xb_add(&gbar[XB_XCNT(xb_xcc_id())], 1u); }
      __syncthreads(); }
#define SEAM(k) do { if (IN(k) && IN((k) + 1)) { xcd_barrier(gbar, bst, (wave == 0 && lane_id() == 0), (unsigned)G); } } while (0)
#define SEAM_ARRIVE(k) do { xcd_barrier_arrive(gbar, bst, (wave == 0 && lane_id() == 0), (unsigned)G); } while (0)
#else
#define SEAM(k) do { } while (0)
#endif
    bf16_t* HI = (bf16_t*)(ws + WS_HI);
    bf16_t* HID = (bf16_t*)(ws + WS_HID);
    const int gw = bid * 8 + wave, NGW = G * 8;

    if (IN(0)) {
        const int lane = lane_id();
        LAS float* scr = (LAS float*)(lds + wave * 16896);
#define TJOB(W_, K_, N_, WT_, GAIN_, MODE_) do { const int ni_ = ((K_) / 64) * (((N_) + 31) / 32); \
            for (int it_ = gw; it_ < ni_; it_ += NGW) transpose_item((W_), (K_), (N_), (bf16_t*)(ws + (WT_)), (GAIN_), (MODE_), scr, it_, lane); } while (0)
        TJOB(args.in[3], DM, FF2, WS_BT1, args.in[2], 1);
        for (int m2 = gw; m2 < MROWS / 2; m2 += NGW) {
            f32x4 v[2][4]; float sq[2];
#pragma unroll
            for (int r = 0; r < 2; ++r) { const f32x4* xr = (const f32x4*)(x + (size_t)(2 * m2 + r) * DM) + lane;
#pragma unroll
                for (int j = 0; j < 4; ++j) v[r][j] = xr[64 * j]; }
#pragma unroll
            for (int r = 0; r < 2; ++r) { float s = 0.f;
#pragma unroll
                for (int j = 0; j < 4; ++j) s += (v[r][j][0] * v[r][j][0] + v[r][j][1] * v[r][j][1]) + (v[r][j][2] * v[r][j][2] + v[r][j][3] * v[r][j][3]);
                sq[r] = s; }
#pragma unroll
            for (int r = 0; r < 2; ++r) { const float ms = wave_sum(sq[r]) * (1.0f / DM) + EPS; const float rs = __builtin_amdgcn_rsqf(ms);
                if (lane == 0) ((float*)(ws + WS_RSX))[2 * m2 + r] = __builtin_amdgcn_sqrtf(ms);
                u32x2* o8 = (u32x2*)(HI + (size_t)(2 * m2 + r) * DM) + lane;
#pragma unroll
                for (int j = 0; j < 4; ++j) { u32x2 o; o.x = pg8::cvt_pk_bf16(v[r][j][0] * rs, v[r][j][1] * rs); o.y = pg8::cvt_pk_bf16(v[r][j][2] * rs, v[r][j][3] * rs); o8[64 * j] = o; } }
        }
        __syncthreads();
    }
    SEAM(0);
    if (IN(1)) {
        pg8::Gemm g{HI, (const bf16_t*)(ws + WS_BT1), MROWS, FF2, DM}; pg8::StaticOrder S; S.init(MROWS, FF2, G, bid);
        pg8::EpiSwiglu E{HID, nullptr};
        pg8::gemm_phase<pg8::EpiSwiglu, pg8::StaticOrder, true, true, 8>(lds, g, S, E, wave);
        {
            LAS int* bc = (LAS int*)(lds + LDS_MISC); LAS float* scr = (LAS float*)(lds + wave * 16896); const int lane = lane_id();
            constexpr int I2 = (FF / 64) * (DM / 32), I3 = (DM / 64) * ((6872 + 31) / 32), ITOT = I2 + I3;
            for (;;) {
                __syncthreads();
                if (wave == 0 && lane == 0) bc[0] = (int)atomicAdd(&ctl[CW_TQ], 1u);
                __syncthreads();
                const int it = bc[0] * 16 + wave;
                if (bc[0] * 16 >= ITOT) break;
                if (it < I2) transpose_pair(args.in[4], FF, DM, (bf16_t*)(ws + WS_BT2), nullptr, 0, scr, it, it + 8, lane);
                else if (it < ITOT) transpose_pair(args.in[6], DM, 6872, (bf16_t*)(ws + WS_BT3), args.in[5], 2, scr, it - I2, it - I2 + 8, lane);
            }
            __syncthreads();
        }
    }
    SEAM(1);
    if (IN(2)) {
        pg8::Gemm g{HID, (const bf16_t*)(ws + WS_BT2), MROWS, DM, FF}; pg8::StaticOrder S; S.init(MROWS, DM, G, bid);
        pg8::EpiResidH E{HI, (float*)(ws + WS_RSS1), 0.5f, lds, (const float*)(ws + WS_RSX)};
        pg8::gemm_phase<pg8::EpiResidH, pg8::StaticOrder>(lds, g, S, E, wave);
    }
    SEAM_ARRIVE(2);
    if (IN(3)) {
        pg8::Gemm g{HI, (const bf16_t*)(ws + WS_BT3), MROWS, NIN, DM}; pg8::AlignedOrder S; S.init(NIN, bid);
        pg8::EpiInproj E{ws, (bf16_t*)out, (const float*)(ws + WS_RSS1), args.in[11], lds};
        BarHook H{gbar, bst, wave};
        pg8::gemm_phase<pg8::EpiInproj, pg8::AlignedOrder, true, true, 8, BarHook>(lds, g, S, E, wave, H);
        {
            LAS int* bc = (LAS int*)(lds + LDS_MISC); LAS float* scr = (LAS float*)(lds + wave * 16896); const int lane = lane_id();
            constexpr int I1 = (DM / 64) * (DM / 32), IP = (PLE / 64) * (DM / 32), IPB = MROWS * PLE / 2048, ITOT = 3 * I1 + IP + IPB;
            bf16_t* PB = (bf16_t*)(ws + WS_PB);
            for (;;) {
                __syncthreads();
                if (wave == 0 && lane == 0) bc[0] = (int)atomicAdd(&ctl[CW_TQ + 3], 1u);
                __syncthreads();
                const int it = bc[0] * 8 + wave;
                if (bc[0] * 8 >= ITOT) break;
                if (it < I1) transpose_item(args.in[10], DM, DM, (bf16_t*)(ws + WS_BTA), nullptr, 0, scr, it, lane);
                else if (it < 2 * I1) transpose_item(args.in[12], DM, DM, (bf16_t*)(ws + WS_BTB), nullptr, 0, scr, it - I1, lane);
                else if (it < 3 * I1) transpose_item(args.in[14], DM, DM, (bf16_t*)(ws + WS_BTO), nullptr, 0, scr, it - 2 * I1, lane);
                else if (it < 3 * I1 + IP) transpose_item(args.in[20], PLE, DM, (bf16_t*)(ws + WS_BTP), nullptr, 0, scr, it - 3 * I1, lane);
                else if (it < ITOT) { const size_t base = (size_t)(it - 3 * I1 - IP) * 2048 + lane * 4; f32x4 v[8];
#pragma unroll
                    for (int u = 0; u < 8; ++u) v[u] = *(const f32x4*)(p + base + u * 256);
#pragma unroll
                    for (int u = 0; u < 8; ++u) { u32x2 o; o.x = pg8::cvt_pk_bf16(v[u][0], v[u][1]); o.y = pg8::cvt_pk_bf16(v[u][2], v[u][3]); *(u32x2*)(PB + base + u * 256) = o; } }
            }
            __syncthreads();
        }
    }
    SEAM(3);
    if (IN(4)) {
        LAS int* bc = (LAS int*)(lds + LDS_MISC);
        float* DECG = (float*)(ws + WS_DECG); float* STATE = (float*)(ws + WS_GLAST);
        { LAS float* RBw = (LAS float*)(lds + DS_RB); const int l_ = lane_id();
          for (int e = wave * 64 + l_; e < 129 * 8; e += 512) RBw[e] = args.in[13][t5_bucket(e >> 3) * 8 + (e & 7)] * 1.4426950408889634f; }
        int qx = (int)(xb_xcc_id() & 7u), qdone = 0;
        for (;;) {
            __syncthreads();
            if (wave == 0 && lane_id() == 0) bc[0] = (int)atomicAdd(&ctl[CW_QUEUE + 64 * qx], 1u);
            __syncthreads();
            const int item = bc[0];
            if (item >= 64 + 20 + 128) { if (++qdone == 8) break; qx = (qx + 1) & 7; continue; }
            if (item < 64) gla_prep_item(qx, item & 3, item >> 2, ws, args.in[7], args.in[8], DECG, ctl + CW_GLACNT, lds, wave);
            else if (item < 72) { const int k = item - 64, sg = k >> 2;
                gla_item<false>(qx, k & 3, 11 * sg, 11 * sg + 11, 0, sg, ws, args.in[9], DECG, STATE, ctl + CW_GLACNT, ctl + CW_GLAST, ctl + CW_TMO, lds, wave); }
            else if (item < 96) dsa_item(qx, 127 - (item - 72), ws, args.in[13], lds, wave);
            else if (item < 108) { const int k = item - 96, sg = k >> 2;
                gla_item<true>(qx, k & 3, 11 * sg, sg == 2 ? 32 : 11 * sg + 11, sg, 0, ws, args.in[9], DECG, STATE, ctl + CW_GLACNT, ctl + CW_GLAST, ctl + CW_TMO, lds, wave); }
            else dsa_item(qx, 127 - (item - 84), ws, args.in[13], lds, wave);
        }
        {
            LAS float* scr = (LAS float*)(lds + wave * 16896); const int lane = lane_id();
            constexpr int ITOT = (DM / 64) * (FF2 / 32);
            for (;;) {
                __syncthreads();
                if (wave == 0 && lane == 0) bc[0] = (int)atomicAdd(&ctl[CW_TQ + 2], 1u);
                __syncthreads();
                const int it = bc[0] * 8 + wave;
                if (bc[0] * 8 >= ITOT) break;
                if (it < ITOT) transpose_item(args.in[16], DM, FF2, (bf16_t*)(ws + WS_BT8), args.in[15], 1, scr, it, lane);
            }
            __syncthreads();
        }
    }
    SEAM(4);
    if (IN(5)) {
        bf16_t* MG = (bf16_t*)(ws + WS_GR);
        { pg8::Gemm g{(const bf16_t*)(ws + WS_GV), (const bf16_t*)(ws + WS_BTA), MROWS, DM, DM}; pg8::StaticOrder S; S.init(MROWS, DM, G, bid);
          pg8::EpiMerge E{MG, (const bf16_t*)out, 0, lds};
          pg8::gemm_phase<pg8::EpiMerge, pg8::StaticOrder>(lds, g, S, E, wave); }
        { pg8::Gemm g{(const bf16_t*)(ws + WS_DQ), (const bf16_t*)(ws + WS_BTB), MROWS, DM, DM}; pg8::StaticOrder S; S.init(MROWS, DM, G, bid);
          pg8::EpiMerge E{MG, (const bf16_t*)out, 1, lds};
          pg8::gemm_phase<pg8::EpiMerge, pg8::StaticOrder>(lds, g, S, E, wave); }
    }
    SEAM_ARRIVE(5);
    if (IN(6)) {
        pg8::Gemm g{(const bf16_t*)(ws + WS_GR), (const bf16_t*)(ws + WS_BTO), MROWS, DM, DM}; pg8::StaticOrder S; S.init(MROWS, DM, G, bid);
        pg8::EpiResidH E{HI, (float*)(ws + WS_RSS2), 1.0f, lds, nullptr};
        BarHook H{gbar, bst, wave};
        pg8::gemm_phase<pg8::EpiResidH, pg8::StaticOrder, true, true, 0, BarHook>(lds, g, S, E, wave, H);
    }
    SEAM_ARRIVE(6);
    if (IN(7)) {
        pg8::Gemm g{HI, (const bf16_t*)(ws + WS_BT8), MROWS, FF2, DM}; pg8::AlignedOrder S; S.init(FF2, bid);
        pg8::EpiSwiglu E{HID, (const float*)(ws + WS_RSS2)};
        BarHook H{gbar, bst, wave};
        pg8::gemm_phase<pg8::EpiSwiglu, pg8::AlignedOrder, true, true, 8, BarHook>(lds, g, S, E, wave, H);
        { const bool half = (G == 256);
          pg8::Gemm g2{(const bf16_t*)(ws + WS_PB), (const bf16_t*)(ws + WS_BTP), MROWS, DM, PLE}; pg8::StaticOrder S2; S2.init(MROWS, DM, half ? 128 : G, half ? (bid >= 128 ? bid - 128 : (1 << 20)) : bid);
          pg8::EpiPle E2{(bf16_t*)(ws + WS_PROJ)};
          pg8::gemm_phase<pg8::EpiPle, pg8::StaticOrder>(lds, g2, S2, E2, wave); }
        {
            LAS int* bc = (LAS int*)(lds + LDS_MISC); LAS float* scr = (LAS float*)(lds + wave * 16896); const int lane = lane_id();
            constexpr int I9 = (FF / 64) * (DM / 32), IG = (DM / 64) * (DM / 32), ITOT = I9 + IG;
            for (;;) {
                __syncthreads();
                if (wave == 0 && lane == 0) bc[0] = (int)atomicAdd(&ctl[CW_TQ + 1], 1u);
                __syncthreads();
                const int it = bc[0] * 8 + wave;
                if (bc[0] * 8 >= ITOT) break;
                if (it < I9) transpose_item(args.in[17], FF, DM, (bf16_t*)(ws + WS_BT9), nullptr, 0, scr, it, lane);
                else if (it < ITOT) transpose_item(args.in[19], DM, DM, (bf16_t*)(ws + WS_BTG), args.in[18], 0, scr, it - I9, lane);
            }
            __syncthreads();
        }
    }
    SEAM(7);
    if (IN(8)) {
        pg8::Gemm g{HID, (const bf16_t*)(ws + WS_BT9), MROWS, DM, FF}; pg8::StaticOrder S; S.init(MROWS, DM, G, bid);
        pg8::EpiResidH E{HI, (float*)(ws + WS_RSS3), 0.5f, lds, nullptr};
        pg8::gemm_phase<pg8::EpiResidH, pg8::StaticOrder>(lds, g, S, E, wave);
    }
    SEAM_ARRIVE(8);
    if (IN(9)) {
        { pg8::Gemm g{HI, (const bf16_t*)(ws + WS_BTG), MROWS, DM, DM}; pg8::StaticOrder S; S.init(MROWS, DM, G, bid);
          pg8::EpiPleFinal E{out, HI, (const bf16_t*)(ws + WS_PROJ), (const float*)(ws + WS_RSS3), args.in[21], (unsigned*)(ws + WS_RSS4), ctl + CW_PLEC, ctl + CW_TMO, lds};
          BarHook H{gbar, bst, wave};
          pg8::gemm_phase<pg8::EpiPleFinal, pg8::StaticOrder, true, true, 0, BarHook>(lds, g, S, E, wave, H); }
    }
#undef IN
#undef SEAM
}

extern "C" void kernel_launch(void* const* d_in, const int* in_sizes, int n_in, void* d_out, int out_size, void* d_ws, size_t ws_size, hipStream_t stream) {
    static int grid = 0;
    if (grid == 0) {
        if (n_in != 22 || out_size != MROWS * DM || ws_size < WS_END) { fprintf(stderr, "kernel_launch: unexpected problem shape (n_in %d out %d ws %zu)\n", n_in, out_size, ws_size); grid = -1; return; }
        int dev = 0, cus = 0, per_cu = 0;
        (void)hipGetDevice(&dev); (void)hipDeviceGetAttribute(&cus, hipDeviceAttributeMultiprocessorCount, dev);
        if (hipFuncSetAttribute((const void*)fwd_kernel, hipFuncAttributeMaxDynamicSharedMemorySize, LDS_BYTES) != hipSuccess) { fprintf(stderr, "kernel_launch: hipFuncSetAttribute failed\n"); grid = -1; return; }
        if (hipOccupancyMaxActiveBlocksPerMultiprocessor(&per_cu, (const void*)fwd_kernel, 512, LDS_BYTES) != hipSuccess || per_cu < 1) { fprintf(stderr, "kernel_launch: occupancy query says %d\n", per_cu); per_cu = 1; }
        (void)hipGetLastError();
        grid = cus * 1;
        if (grid > 256) grid = 256;
    }
    if (grid < 0) return;
    (void)hipMemsetAsync((char*)d_ws + WS_CTL, 0, CTL_BYTES, stream);
    Args a{};
    for (int i = 0; i < 22; ++i) a.in[i] = (const float*)d_in[i];
    a.out = (float*)d_out; a.ws = (unsigned char*)d_ws;
    if (MK_N_LAUNCHES == 1) {
        a.ph_lo = 0; a.ph_hi = NPHASE;
        void* kargs[] = {&a};
        hipError_t e = hipLaunchCooperativeKernel((const void*)fwd_kernel, dim3(grid), dim3(512), kargs, LDS_BYTES, stream);
        if (e != hipSuccess) fprintf(stderr, "cooperative launch failed: %s (grid %d)\n", hipGetErrorString(e), grid);
    } else {
        for (int ph = 0; ph < NPHASE; ++ph) {
            a.ph_lo = ph; a.ph_hi = ph + 1;
            hipLaunchKernelGGL(fwd_kernel, dim3(grid), dim3(512), LDS_BYTES, stream, a);
        }
    }
}
```
